# Optimizing an MI355X kernel written in HIP

```python
import math
import jax, jax.numpy as jnp
from jax import lax
import numpy as np

D_MODEL = 2048
BATCH = 2
SEQ = 16384
DEPTH = 4
DEC_BATCH = 8
DEC_SEQ = 2048
PAST_LEN = 128

GRID_W = 64
MLA_HEADS = 8
MLA_Q_RANK = 512
MLA_KV_RANK = 256
MLA_NOPE = 128
MLA_ROPE = 64
MLA_V = 128
ROPE_THETA = 10000.0
NA_HEADS = 4
NA_HEAD_DIM = 128
NA_WIN_ROWS = 8
NA_WIN_COLS = 16
DIFF_HEADS = 4
DIFF_QK_DIM = 64
DIFF_V_DIM = 2 * DIFF_QK_DIM
IN_SPLITS = (MLA_Q_RANK, MLA_KV_RANK, MLA_ROPE,
             NA_HEADS * NA_HEAD_DIM, NA_HEADS * NA_HEAD_DIM, NA_HEADS * NA_HEAD_DIM,
             DIFF_HEADS * 2 * DIFF_QK_DIM, DIFF_HEADS * 2 * DIFF_QK_DIM, DIFF_HEADS * DIFF_V_DIM)
IN_WIDTH = sum(IN_SPLITS)
MIX_WIDTH = MLA_HEADS * MLA_V + NA_HEADS * NA_HEAD_DIM + DIFF_HEADS * DIFF_V_DIM
D_FF = 5632
CONV_W = 3
PLE_DIM = 256
QUERY_BLOCK = 128
RMS_EPS = 1e-6

kernel_name = 'hybrid_mla_natten_diff_encoder'


def _rmsnorm(x, g):
    xf = x.astype(jnp.float32)
    y = xf * lax.rsqrt(jnp.mean(xf * xf, axis=-1, keepdims=True) + RMS_EPS)
    return (y * g.astype(jnp.float32)).astype(x.dtype)


def _rope(x, pos):
    half = x.shape[-1] // 2
    freqs = jnp.power(ROPE_THETA, -jnp.arange(half, dtype=jnp.float32) / half)
    ang = pos.astype(jnp.float32)[:, None] * freqs[None, :]
    bshape = (1, pos.shape[0]) + (1,) * (x.ndim - 3) + (half,)
    cos = jnp.cos(ang).reshape(bshape)
    sin = jnp.sin(ang).reshape(bshape)
    xf = x.astype(jnp.float32)
    x1, x2 = xf[..., :half], xf[..., half:]
    return jnp.concatenate([x1 * cos - x2 * sin, x1 * sin + x2 * cos], axis=-1).astype(x.dtype)


def _to_blocks(x):
    b, l = x.shape[:2]
    return x.reshape((b, l // QUERY_BLOCK, QUERY_BLOCK) + x.shape[2:]).swapaxes(0, 1)


def _from_blocks(y):
    nb, b, qb = y.shape[:3]
    return y.swapaxes(0, 1).reshape((b, nb * qb) + y.shape[3:])


def _mla_attention(q, k, v):
    scale = (MLA_NOPE + MLA_ROPE) ** -0.5

    def block(qb):
        s = jnp.einsum('bqhd,bkhd->bhqk', qb, k).astype(jnp.float32) * scale
        p = jax.nn.softmax(s, axis=-1).astype(v.dtype)
        return jnp.einsum('bhqk,bkhd->bqhd', p, v)

    return _from_blocks(lax.map(block, _to_blocks(q)))


def _diff_attention(q1, q2, k1, k2, v, lam):
    seq_len = k1.shape[1]
    scale = DIFF_QK_DIM ** -0.5
    slopes = jnp.exp2(-8.0 * jnp.arange(1, DIFF_HEADS + 1, dtype=jnp.float32) / DIFF_HEADS)
    key_pos = jnp.arange(seq_len, dtype=jnp.int32)

    def block(args):
        q1b, q2b, start = args
        qpos = start + jnp.arange(QUERY_BLOCK, dtype=jnp.int32)
        dist = jnp.abs(qpos[:, None] - key_pos[None, :]).astype(jnp.float32)
        bias = -slopes[:, None, None] * dist[None]
        s1 = jnp.einsum('bqhd,bkhd->bhqk', q1b, k1).astype(jnp.float32) * scale + bias
        s2 = jnp.einsum('bqhd,bkhd->bhqk', q2b, k2).astype(jnp.float32) * scale + bias
        a = jax.nn.softmax(s1, axis=-1) - lam * jax.nn.softmax(s2, axis=-1)
        return jnp.einsum('bhqk,bkhd->bqhd', a.astype(v.dtype), v)

    starts = jnp.arange(seq_len // QUERY_BLOCK, dtype=jnp.int32) * QUERY_BLOCK
    return _from_blocks(lax.map(block, (_to_blocks(q1), _to_blocks(q2), starts)))


def _neighbourhood_attention(q, k, v, rpb):
    b, seq_len, nh, dh = q.shape
    rows = seq_len // GRID_W
    wr = min(NA_WIN_ROWS, rows)
    wc = NA_WIN_COLS
    nk = wr * wc
    scale = dh ** -0.5
    col = jnp.arange(GRID_W, dtype=jnp.int32)
    col_start = jnp.clip(col - wc // 2, 0, GRID_W - wc)
    key_col = col_start[:, None] + jnp.arange(wc, dtype=jnp.int32)[None, :]
    col_off = key_col - col[:, None] + (NA_WIN_COLS - 1)
    drow = jnp.arange(wr, dtype=jnp.int32)

    def row_block(args):
        q_row, r = args
        row_start = jnp.clip(r - wr // 2, 0, rows - wr)
        key_row = row_start + drow
        idx = (key_row[None, :, None] * GRID_W + key_col[:, None, :]).reshape(GRID_W, nk)
        k_sel = k[:, idx]
        v_sel = v[:, idx]
        row_off = key_row - r + (NA_WIN_ROWS - 1)
        bias = rpb[:, row_off[None, :, None], col_off[:, None, :]].reshape(nh, GRID_W, nk)
        s = jnp.einsum('bqhd,bqkhd->bhqk', q_row, k_sel).astype(jnp.float32) * scale
        s = s + bias.astype(jnp.float32)[None]
        p = jax.nn.softmax(s, axis=-1).astype(v.dtype)
        return jnp.einsum('bhqk,bqkhd->bqhd', p, v_sel)

    q_rows = q.reshape(b, rows, GRID_W, nh, dh).swapaxes(0, 1)
    out = lax.map(row_block, (q_rows, jnp.arange(rows, dtype=jnp.int32)))
    return out.swapaxes(0, 1).reshape(b, seq_len, nh * dh)


def _token_mixers(hn, pos, layer, w_in, g_qa, w_qb, g_kva, w_kvb, rpb,
                  lam_q1, lam_k1, lam_q2, lam_k2, g_subln):
    b, seq_len, _ = hn.shape
    z = hn @ w_in
    offsets = [int(o) for o in np.cumsum(IN_SPLITS)[:-1]]
    c_q, c_kv, k_pe, na_q, na_k, na_v, d_q, d_k, d_v = jnp.split(z, offsets, axis=-1)

    q = (_rmsnorm(c_q, g_qa) @ w_qb).reshape(b, seq_len, MLA_HEADS, MLA_NOPE + MLA_ROPE)
    q = jnp.concatenate([q[..., :MLA_NOPE], _rope(q[..., MLA_NOPE:], pos)], axis=-1)
    kv = (_rmsnorm(c_kv, g_kva) @ w_kvb).reshape(b, seq_len, MLA_HEADS, MLA_NOPE + MLA_V)
    k_pe = _rope(k_pe, pos)
    k = jnp.concatenate([kv[..., :MLA_NOPE],
                         jnp.broadcast_to(k_pe[:, :, None, :], (b, seq_len, MLA_HEADS, MLA_ROPE))], axis=-1)
    o_mla = _mla_attention(q, k, kv[..., MLA_NOPE:]).reshape(b, seq_len, MLA_HEADS * MLA_V)

    na_shape = (b, seq_len, NA_HEADS, NA_HEAD_DIM)
    o_na = _neighbourhood_attention(na_q.reshape(na_shape), na_k.reshape(na_shape),
                                    na_v.reshape(na_shape), rpb)

    lam_init = 0.8 - 0.6 * math.exp(-0.3 * layer)
    f32 = jnp.float32
    lam = (jnp.exp(jnp.sum(lam_q1.astype(f32) * lam_k1.astype(f32)))
           - jnp.exp(jnp.sum(lam_q2.astype(f32) * lam_k2.astype(f32))) + lam_init)
    dq = d_q.reshape(b, seq_len, DIFF_HEADS, 2, DIFF_QK_DIM)
    dk = d_k.reshape(b, seq_len, DIFF_HEADS, 2, DIFF_QK_DIM)
    o_diff = _diff_attention(dq[..., 0, :], dq[..., 1, :], dk[..., 0, :], dk[..., 1, :],
                             d_v.reshape(b, seq_len, DIFF_HEADS, DIFF_V_DIM), lam)
    o_diff = (_rmsnorm(o_diff, g_subln) * (1.0 - lam_init)).reshape(b, seq_len, DIFF_HEADS * DIFF_V_DIM)

    return jnp.concatenate([o_mla, o_na, o_diff], axis=-1)


def _dwconv(g, w, bias):
    seq_len = g.shape[1]
    gp = jnp.pad(g, ((0, 0), (1, 1), (0, 0)))
    return gp[:, :seq_len] * w[0] + gp[:, 1:seq_len + 1] * w[1] + gp[:, 2:] * w[2] + bias


def _trunk(h, p, g_attn, w_in, g_qa, w_qb, g_kva, w_kvb, rpb, lam_q1, lam_k1, lam_q2, lam_k2,
           g_subln, w_out, g_ffn, w_gu, conv_w, conv_b, w_down, g_ple, w_plg, w_ple, g_final):
    pos = jnp.arange(h.shape[1], dtype=jnp.int32)
    for i in range(DEPTH):
        mix = _token_mixers(_rmsnorm(h, g_attn[i]), pos, i, w_in[i], g_qa[i], w_qb[i], g_kva[i],
                            w_kvb[i], rpb[i], lam_q1[i], lam_k1[i], lam_q2[i], lam_k2[i], g_subln[i])
        h = h + mix @ w_out[i]
        gate_branch, up_branch = jnp.split(_rmsnorm(h, g_ffn[i]) @ w_gu[i], 2, axis=-1)
        h = h + (jax.nn.gelu(_dwconv(gate_branch, conv_w[i], conv_b[i])) * up_branch) @ w_down[i]
        ple_gate = jax.nn.sigmoid(_rmsnorm(h, g_ple[i]) @ w_plg[i])
        h = h + (p[i] @ w_ple[i]) * ple_gate
    return _rmsnorm(h, g_final)


def setup_inputs(seed: int = 0) -> dict:
    key = jax.random.key(seed)
    ks = jax.random.split(key, 26)
    f32 = jnp.float32

    def nrm(k, shape, scale):
        return jax.random.normal(k, shape, f32) * scale

    def gain(k, shape):
        return 1.0 + 0.02 * jax.random.normal(k, shape, f32)

    return {
        'x_prompt': nrm(ks[0], (BATCH, SEQ, D_MODEL), 1.0),
        'x_sample': nrm(ks[1], (DEC_BATCH, DEC_SEQ, D_MODEL), 1.0),
        'p_prompt': nrm(ks[2], (DEPTH, BATCH, SEQ, PLE_DIM), 1.0),
        'p_sample': nrm(ks[3], (DEPTH, DEC_BATCH, DEC_SEQ, PLE_DIM), 1.0),
        'g_attn': gain(ks[4], (DEPTH, D_MODEL)),
        'w_in': nrm(ks[5], (DEPTH, D_MODEL, IN_WIDTH), D_MODEL ** -0.5),
        'g_qa': gain(ks[6], (DEPTH, MLA_Q_RANK)),
        'w_qb': nrm(ks[7], (DEPTH, MLA_Q_RANK, MLA_HEADS * (MLA_NOPE + MLA_ROPE)), MLA_Q_RANK ** -0.5),
        'g_kva': gain(ks[8], (DEPTH, MLA_KV_RANK)),
        'w_kvb': nrm(ks[9], (DEPTH, MLA_KV_RANK, MLA_HEADS * (MLA_NOPE + MLA_V)), MLA_KV_RANK ** -0.5),
        'rpb': nrm(ks[10], (DEPTH, NA_HEADS, 2 * NA_WIN_ROWS - 1, 2 * NA_WIN_COLS - 1), 0.1),
        'lam_q1': nrm(ks[11], (DEPTH, DIFF_QK_DIM), 0.1),
        'lam_k1': nrm(ks[12], (DEPTH, DIFF_QK_DIM), 0.1),
        'lam_q2': nrm(ks[13], (DEPTH, DIFF_QK_DIM), 0.1),
        'lam_k2': nrm(ks[14], (DEPTH, DIFF_QK_DIM), 0.1),
        'g_subln': gain(ks[15], (DEPTH, DIFF_V_DIM)),
        'w_out': nrm(ks[16], (DEPTH, MIX_WIDTH, D_MODEL), MIX_WIDTH ** -0.5),
        'g_ffn': gain(ks[17], (DEPTH, D_MODEL)),
        'w_gu': nrm(ks[18], (DEPTH, D_MODEL, 2 * D_FF), D_MODEL ** -0.5),
        'conv_w': nrm(ks[19], (DEPTH, CONV_W, D_FF), CONV_W ** -0.5),
        'conv_b': nrm(ks[20], (DEPTH, D_FF), 0.01),
        'w_down': nrm(ks[21], (DEPTH, D_FF, D_MODEL), D_FF ** -0.5),
        'g_ple': gain(ks[22], (DEPTH, D_MODEL)),
        'w_plg': nrm(ks[23], (DEPTH, D_MODEL, D_MODEL), D_MODEL ** -0.5),
        'w_ple': nrm(ks[24], (DEPTH, PLE_DIM, D_MODEL), PLE_DIM ** -0.5),
        'g_final': gain(ks[25], (D_MODEL,)),
    }


def reference(x_prompt, x_sample, p_prompt, p_sample, g_attn, w_in, g_qa, w_qb, g_kva, w_kvb, rpb,
              lam_q1, lam_k1, lam_q2, lam_k2, g_subln, w_out, g_ffn, w_gu, conv_w, conv_b, w_down,
              g_ple, w_plg, w_ple, g_final):
    weights = (g_attn, w_in, g_qa, w_qb, g_kva, w_kvb, rpb, lam_q1, lam_k1, lam_q2, lam_k2,
               g_subln, w_out, g_ffn, w_gu, conv_w, conv_b, w_down, g_ple, w_plg, w_ple, g_final)
    y_prompt = _trunk(x_prompt, p_prompt, *weights)
    y_sample = _trunk(x_sample, p_sample, *weights)
    return (y_prompt, y_sample)
```

```cpp
#include <hip/hip_runtime.h>
#include <cstdio>
#include <cstdint>

#ifndef MK_ONE_LAUNCH
#define MK_ONE_LAUNCH 1
#endif
#ifndef MLA_SDEPTH
#define MLA_SDEPTH 2
#endif

#define LAS __attribute__((address_space(3)))
#define GAS __attribute__((address_space(1)))
typedef unsigned short bf16;
typedef short bf16x8 __attribute__((ext_vector_type(8)));
typedef short s16x4 __attribute__((ext_vector_type(4)));
typedef float f32x2 __attribute__((ext_vector_type(2)));
typedef float f32x4 __attribute__((ext_vector_type(4)));
typedef float f32x16 __attribute__((ext_vector_type(16)));
typedef unsigned u32x2 __attribute__((ext_vector_type(2)));
typedef unsigned u32x4 __attribute__((ext_vector_type(4)));
typedef GAS unsigned gu32;

constexpr int DM = 2048, LP = 16384, LS = 2048, MP = 2 * LP, MS = 8 * LS, M = MP + MS;
constexpr int DEPTH = 4, IN_W = 3904, ZLD = 4096, DFF = 5632, PLE = 256;
constexpr int QW = 1536, KVW = 2048, VW = 1024;
constexpr float RMS_EPS = 1e-6f, LOG2E = 1.4426950408889634f;
constexpr int Z_CQ = 0, Z_CKV = 512, Z_NAQ = 768, Z_NAK = 1280, Z_NAV = 1792, Z_DQ = 2304, Z_DK = 2816, Z_DV = 3328, Z_KPE = 3840;
constexpr float SC_MLA = 0.07216878364870322f * LOG2E;
constexpr float SC_NA = 0.08838834764831845f * LOG2E;
constexpr float SC_DIFF = 0.125f * LOG2E;
constexpr int GU_TOK = 252;
constexpr int GU_NM = (M + GU_TOK - 1) / GU_TOK;

constexpr size_t MiB = 1u << 20;
constexpr size_t WS_CTL = 0, CTL_ZERO_BYTES = 1 * MiB;
constexpr size_t WS_ROPE = 1 * MiB;
constexpr size_t WS_QN = 5 * MiB;
constexpr size_t WS_KN = 6 * MiB + 512 * 1024;
constexpr size_t WS_WIN = 8 * MiB;
constexpr size_t WS_WQB = 24 * MiB;
constexpr size_t WS_WKVB = 26 * MiB;
constexpr size_t WS_WOUT = 27 * MiB;
constexpr size_t WS_WGU = 35 * MiB;
constexpr size_t WS_WDOWN = 79 * MiB;
constexpr size_t WS_WPLG = 101 * MiB;
constexpr size_t WS_WPLE = 109 * MiB;
constexpr size_t WS_PB = 112 * MiB;
constexpr size_t WS_A = 137 * MiB;
constexpr size_t WS_Z = 330 * MiB;
constexpr size_t WS_QM = 714 * MiB;
constexpr size_t WS_KM = 858 * MiB;
constexpr size_t WS_VM = 1002 * MiB;
constexpr size_t WS_DO = 1098 * MiB;
constexpr size_t WS_CQN = 1290 * MiB;
constexpr size_t WS_CKVN = 1338 * MiB;
constexpr size_t WS_SELF = 1362 * MiB;
constexpr size_t WS_END = 1364 * MiB;
constexpr size_t WS_ACT = 330 * MiB;
constexpr size_t WS_PLEB = 858 * MiB;
static_assert(WS_ACT + (size_t)M * DFF * 2 <= WS_KM && WS_PLEB + (size_t)M * DM * 2 <= WS_DO, "overlay map");
constexpr int CW_BAR = 4096;
constexpr int CW_DYN = 16384;

constexpr int RING_BYTES = 131072;
constexpr int MISC_OFF = RING_BYTES + 320;
constexpr int LDS_BYTES = 147456;
constexpr int NWAVES = 8;

#define RLX_AGENT __ATOMIC_RELAXED, __HIP_MEMORY_SCOPE_AGENT
#define LDS_WAIT() asm volatile("s_waitcnt lgkmcnt(0)" ::: "memory")
#define VM_WAIT() asm volatile("s_waitcnt vmcnt(0)" ::: "memory")
#define SBAR() __builtin_amdgcn_sched_barrier(0)

__device__ __forceinline__ unsigned f2bf(float f) { unsigned u = __builtin_bit_cast(unsigned, f); return (u + 0x7fffu + ((u >> 16) & 1u)) >> 16; }
__device__ __forceinline__ unsigned pk2(float lo, float hi) { return f2bf(lo) | (f2bf(hi) << 16); }
typedef __bf16 bf16x2_t __attribute__((ext_vector_type(2)));
typedef float f32x2_t __attribute__((ext_vector_type(2)));
__device__ __forceinline__ unsigned cvt_pk_bf16(float lo, float hi) { const f32x2_t v = {lo, hi}; return __builtin_bit_cast(unsigned, __builtin_convertvector(v, bf16x2_t)); }
__device__ __forceinline__ float bf_lo(unsigned w) { return __builtin_bit_cast(float, w << 16); }
__device__ __forceinline__ float bf_hi(unsigned w) { return __builtin_bit_cast(float, w & 0xffff0000u); }
__device__ __forceinline__ int lane_now() { int ln; asm volatile("v_mbcnt_lo_u32_b32 %0, -1, 0\n\tv_mbcnt_hi_u32_b32 %0, -1, %0" : "=&v"(ln)); return ln; }
__device__ __forceinline__ int opaque_tid(int wv) { const int ln = lane_now(); asm volatile("" : "+s"(wv)); return (wv << 6) | ln; }
template <int X> __device__ __forceinline__ float swz_xor(float v) { return __builtin_bit_cast(float, __builtin_amdgcn_ds_swizzle(__builtin_bit_cast(int, v), (X << 10) | 0x1f)); }
__device__ __forceinline__ float half_sum16(float v) { v += swz_xor<1>(v); v += swz_xor<2>(v); v += swz_xor<4>(v); v += swz_xor<8>(v); return v; }
__device__ __forceinline__ void xhalf_swap(float& a, float& b) { asm("s_nop 1\n\tv_permlane32_swap_b32 %0, %1" : "+v"(a), "+v"(b)); }
__device__ __forceinline__ float xhalf_sum(float v) { float a = v, b = v; xhalf_swap(a, b); return a + b; }
__device__ __forceinline__ float xhalf_max(float v) { float a = v, b = v; xhalf_swap(a, b); return fmaxf(a, b); }
__device__ __forceinline__ float wave_sum(float v) {
    v = half_sum16(v); v += swz_xor<16>(v);
    return xhalf_sum(v);
}
__device__ __forceinline__ float wave_max(float v) {
    v = fmaxf(v, swz_xor<1>(v)); v = fmaxf(v, swz_xor<2>(v)); v = fmaxf(v, swz_xor<4>(v)); v = fmaxf(v, swz_xor<8>(v)); v = fmaxf(v, swz_xor<16>(v));
    return xhalf_max(v);
}
__device__ __forceinline__ float lane_read(float v, int srclane) { return __builtin_bit_cast(float, __builtin_amdgcn_ds_bpermute(srclane << 2, __builtin_bit_cast(int, v))); }
__device__ __forceinline__ int seq_mask(int row) { return row < MP ? (LP - 1) : (LS - 1); }
__device__ __forceinline__ float gelu_tanh(float x) {
    const float t = x * __builtin_fmaf(x * x, 0.0356774081f, 0.7978845608f);
    const float e = __builtin_amdgcn_exp2f(-2.885390082f * t);
    return x * __builtin_amdgcn_rcpf(1.f + e);
}
__device__ __forceinline__ float sigmoidf_(float x) { return __builtin_amdgcn_rcpf(1.f + __builtin_amdgcn_exp2f(-LOG2E * x)); }

namespace pg8 {
constexpr int BM = 256, BK = 64, HALF = 128, HTB = HALF * BK * 2, NXCD = 8, WGM = 8;
__host__ __device__ __forceinline__ int lds_byte(int r, int c) { const int st = (r >> 4) * 2 + (c >> 5), rr = r & 15, cc = c & 31, ob = rr * 64 + cc * 2; return st * 1024 + (ob ^ (((ob >> 9) & 1) << 5)); }
__host__ __device__ __forceinline__ void stage_rc(int b, int& R, int& C) { const int st = b / 1024, sb = b % 1024, swz = sb ^ (((sb >> 9) & 1) << 5); R = (st >> 1) * 16 + swz / 64; C = (st & 1) * 32 + (swz % 64) / 2; }
__host__ __device__ __forceinline__ int perm32(int rho) { const int n = rho >> 4, i = rho & 15; return 8 * (i >> 2) + 4 * n + (i & 3); }

struct Unit { int pm, pn; };
struct Gemm { const bf16* A; const bf16* Bt; int lda, K; };

struct StaticOrder {
    int nM, nN, nwg, G, c;
    __device__ void init(int nM_, int nN_, int G_, int c_) { nM = nM_; nN = nN_; nwg = nM * nN; G = G_; c = c_; }
    __device__ bool next(int i, Unit& u) const {
        const long L = (long)i * G + c; if (L >= nwg) return false;
        int wgid = (int)L; { const int q = nwg / NXCD, r = nwg % NXCD, xcd = wgid % NXCD, off = wgid / NXCD; wgid = (xcd < r ? xcd * (q + 1) : r * (q + 1) + (xcd - r) * q) + off; }
        const int nig = WGM * nN, gid = wgid / nig, fm = gid * WGM, gsz = (nM - fm) < WGM ? (nM - fm) : WGM;
        u.pm = fm + ((wgid % nig) % gsz); u.pn = (wgid % nig) / gsz; return true;
    }
};

template <class Epi, bool PERMA>
__device__ __forceinline__ void gemm_phase(LAS unsigned char* lds, const Gemm g, const StaticOrder& S, const Epi& E, int wv) {
    const int tid = opaque_tid(wv), wid = __builtin_amdgcn_readfirstlane(tid >> 6), lane = tid & 63, wr = wid >> 2, wc = wid & 3, fr = lane & 15, fq = lane >> 4;
    const int K = g.K, lda = g.lda, nt = K / BK;
    unsigned voffA[2], voffB[2];
#pragma unroll
    for (int i = 0; i < 2; ++i) { int R, C; stage_rc(tid * 16 + i * 8192, R, C); const int Rb = (R & ~31) + perm32(R & 31);
        const int Ra = PERMA ? (126 * (R >> 6) + 8 * (R & 15) + ((R >> 4) & 3)) : R;
        voffA[i] = (unsigned)(Ra * lda + C) * 2u; voffB[i] = (unsigned)(Rb * K + C) * 2u; }
    const size_t kstep = (size_t)(BK * 2);
    const size_t hstepA = PERMA ? (size_t)4 * lda * 2 : (size_t)HALF * lda * 2;
    const size_t hstepB = (size_t)HALF * K * 2;
    const size_t tstepB = 2 * hstepB;
    const unsigned ldsw = (unsigned)wid * 1024u;
    const int aoff = lds_byte(wr * 64 + fr, fq * 8), boff = lds_byte(wc * 32 + fr, fq * 8);
#define PG8_ABASE(pm) (PERMA ? ((long)(pm) * GU_TOK - 1) * (long)lda * 2 : (long)(pm) * BM * (long)lda * 2)
#define PG8_SA(b, h) (((b) * 2 + (h)) * HTB)
#define PG8_SB(b, h) ((4 + (b) * 2 + (h)) * HTB)
#define PG8_STAGE(bufoff, gbase, voff) do { _Pragma("unroll") for (int _i = 0; _i < 2; ++_i) \
        __builtin_amdgcn_global_load_lds((const unsigned*)((const char*)(gbase) + (voff)[_i]), (LAS unsigned*)(lds + (bufoff) + ldsw + _i * 8192), 16, 0, 0); } while (0)
#define PG8_LDA(dst, b, h) do { _Pragma("unroll") for (int m = 0; m < 4; ++m) _Pragma("unroll") for (int k = 0; k < 2; ++k) dst[m][k] = *(const LAS bf16x8*)(lds + PG8_SA(b, h) + aoff + m * 2048 + k * 1024); } while (0)
#define PG8_LDB(dst, b, h) do { _Pragma("unroll") for (int n = 0; n < 2; ++n) _Pragma("unroll") for (int k = 0; k < 2; ++k) dst[n][k] = *(const LAS bf16x8*)(lds + PG8_SB(b, h) + boff + n * 2048 + k * 1024); } while (0)
#define PG8_MMA(ai, bj, At, Bt) do { __builtin_amdgcn_s_setprio(1); _Pragma("unroll") for (int m = 0; m < 4; ++m) _Pragma("unroll") for (int n = 0; n < 2; ++n) _Pragma("unroll") for (int k = 0; k < 2; ++k) \
        acc[ai][bj][m][n] = __builtin_amdgcn_mfma_f32_16x16x32_bf16(Bt[n][k], At[m][k], acc[ai][bj][m][n], 0, 0, 0); __builtin_amdgcn_s_setprio(0); } while (0)
#define PG8_WAIT_V(n) asm volatile("s_waitcnt vmcnt(" #n ")" ::: "memory")
#define PG8_WAIT_L(n) asm volatile("s_waitcnt lgkmcnt(" #n ")" ::: "memory")
#define PG8_BAR __builtin_amdgcn_s_barrier()
#define PG8_SCHED __builtin_amdgcn_sched_barrier(0)
    Unit cur, nxt; int ui = 0;
    if (!S.next(0, cur)) return;
    f32x4 acc[2][2][4][2];
#pragma unroll
    for (int a = 0; a < 2; ++a)
#pragma unroll
        for (int b = 0; b < 2; ++b)
#pragma unroll
            for (int m = 0; m < 4; ++m)
#pragma unroll
                for (int n = 0; n < 2; ++n) acc[a][b][m][n] = (f32x4){0.f, 0.f, 0.f, 0.f};
    bf16x8 At[4][2], B0[2][2], B1[2][2];
    const char* cA = (const char*)g.A + PG8_ABASE(cur.pm); const char* cB = (const char*)g.Bt + (size_t)cur.pn * tstepB;
    PG8_STAGE(PG8_SB(0, 0), cB, voffB); PG8_STAGE(PG8_SB(0, 1), cB + hstepB, voffB); PG8_STAGE(PG8_SA(0, 0), cA, voffA); PG8_STAGE(PG8_SA(0, 1), cA + hstepA, voffA);
    if (wr == 1) PG8_BAR;
    PG8_WAIT_V(2); PG8_BAR;
    PG8_STAGE(PG8_SB(1, 0), cB + kstep, voffB); PG8_STAGE(PG8_SA(1, 0), cA + kstep, voffA); PG8_STAGE(PG8_SB(1, 1), cB + hstepB + kstep, voffB);
    PG8_WAIT_V(6); PG8_BAR;
    for (;;) {
        const bool has_next = S.next(ui + 1, nxt);
        const char* nA = has_next ? (const char*)g.A + PG8_ABASE(nxt.pm) : cA; const char* nB = has_next ? (const char*)g.Bt + (size_t)nxt.pn * tstepB : cB;
#pragma unroll 1
        for (int t = 0; t < nt; t += 2) {
            const bool last = (t == nt - 2);
            const char* a1 = cA + (size_t)(t + 1) * kstep;
            const char* a2 = last ? nA : cA + (size_t)(t + 2) * kstep; const char* b2 = last ? nB : cB + (size_t)(t + 2) * kstep;
            const char* a3 = a2 + kstep; const char* b3 = b2 + kstep;
            PG8_LDB(B0, 0, 0); PG8_LDB(B1, 0, 1); PG8_SCHED; PG8_LDA(At, 0, 0); PG8_STAGE(PG8_SA(1, 1), a1 + hstepA, voffA);
            PG8_WAIT_V(8); PG8_WAIT_L(0); PG8_BAR; PG8_MMA(0, 0, At, B0); PG8_MMA(0, 1, At, B1); PG8_BAR; PG8_SCHED;
            PG8_LDA(At, 0, 1); PG8_STAGE(PG8_SB(0, 0), b2, voffB); PG8_STAGE(PG8_SB(0, 1), b2 + hstepB, voffB); PG8_STAGE(PG8_SA(0, 0), a2, voffA);
            PG8_WAIT_V(8); PG8_WAIT_L(0); PG8_BAR; PG8_MMA(1, 0, At, B0); PG8_MMA(1, 1, At, B1); PG8_BAR; PG8_SCHED;
            PG8_LDB(B0, 1, 0); PG8_LDB(B1, 1, 1); PG8_SCHED; PG8_LDA(At, 1, 0); PG8_STAGE(PG8_SA(0, 1), a2 + hstepA, voffA);
            PG8_WAIT_V(8); PG8_WAIT_L(0); PG8_BAR; PG8_MMA(0, 0, At, B0); PG8_MMA(0, 1, At, B1); PG8_BAR; PG8_SCHED;
            PG8_LDA(At, 1, 1); PG8_STAGE(PG8_SB(1, 0), b3, voffB); PG8_STAGE(PG8_SB(1, 1), b3 + hstepB, voffB); PG8_STAGE(PG8_SA(1, 0), a3, voffA);
            PG8_WAIT_V(8); PG8_WAIT_L(0); PG8_BAR; PG8_MMA(1, 0, At, B0); PG8_MMA(1, 1, At, B1); PG8_BAR; PG8_SCHED;
        }
        if (wr == 0) PG8_BAR;
        E(acc, cur, wr, wc, fr, fq);
        if (!has_next) break;
#pragma unroll
        for (int a = 0; a < 2; ++a)
#pragma unroll
            for (int b = 0; b < 2; ++b)
#pragma unroll
                for (int m = 0; m < 4; ++m)
#pragma unroll
                    for (int n = 0; n < 2; ++n) acc[a][b][m][n] = (f32x4){0.f, 0.f, 0.f, 0.f};
        cur = nxt; cA = nA; cB = nB; ++ui;
        if (wr == 1) PG8_BAR;
    }
    PG8_WAIT_V(0);
    PG8_BAR;
#undef PG8_ABASE
#undef PG8_SA
#undef PG8_SB
#undef PG8_STAGE
#undef PG8_LDA
#undef PG8_LDB
#undef PG8_MMA
#undef PG8_WAIT_V
#undef PG8_WAIT_L
#undef PG8_BAR
#undef PG8_SCHED
}

__device__ __forceinline__ u32x4 pack8(f32x4 v0, f32x4 v1) { u32x4 w; w.x = cvt_pk_bf16(v0[0], v0[1]); w.y = cvt_pk_bf16(v0[2], v0[3]); w.z = cvt_pk_bf16(v1[0], v1[1]); w.w = cvt_pk_bf16(v1[2], v1[3]); return w; }

struct EpiZ {
    bf16* Z;
    __device__ __forceinline__ void operator()(const f32x4 (&acc)[2][2][4][2], const Unit& u, int wr, int wc, int fr, int fq) const {
        const float sc = (u.pn == 3 || u.pn == 4) ? SC_NA : ((u.pn == 9 || u.pn == 10) ? SC_DIFF : 1.f);
        const int row0 = u.pm * BM + wr * 64 + fr, col0 = u.pn * BM + wc * 32 + 8 * fq;
#pragma unroll
        for (int ai = 0; ai < 2; ++ai)
#pragma unroll
            for (int m = 0; m < 4; ++m) { bf16* rowp = Z + (size_t)(row0 + ai * HALF + m * 16) * ZLD + col0;
#pragma unroll
                for (int bj = 0; bj < 2; ++bj) { u32x4 w = pack8(acc[ai][bj][m][0] * sc, acc[ai][bj][m][1] * sc);
                    *(u32x4*)(rowp + bj * HALF) = w; } }
    }
};
struct EpiStore {
    bf16* O; int ldc;
    __device__ __forceinline__ void operator()(const f32x4 (&acc)[2][2][4][2], const Unit& u, int wr, int wc, int fr, int fq) const {
        const int row0 = u.pm * BM + wr * 64 + fr, col0 = u.pn * BM + wc * 32 + 8 * fq;
#pragma unroll
        for (int ai = 0; ai < 2; ++ai)
#pragma unroll
            for (int m = 0; m < 4; ++m) { bf16* rowp = O + (size_t)(row0 + ai * HALF + m * 16) * ldc + col0;
#pragma unroll
                for (int bj = 0; bj < 2; ++bj) *(u32x4*)(rowp + bj * HALF) = pack8(acc[ai][bj][m][0], acc[ai][bj][m][1]); }
    }
};
struct EpiQ {
    bf16* Q; const float* rope;
    __device__ __forceinline__ void operator()(const f32x4 (&acc)[2][2][4][2], const Unit& u, int wr, int wc, int fr, int fq) const {
        const int row0 = u.pm * BM + wr * 64 + fr;
#pragma unroll
        for (int bj = 0; bj < 2; ++bj) {
            const int c8 = u.pn * BM + bj * HALF + wc * 32 + 8 * fq, cin = c8 % 192; const bool isrope = cin >= 128; const int j0 = (cin - 128) >> 1;
#pragma unroll
            for (int ai = 0; ai < 2; ++ai)
#pragma unroll
                for (int m = 0; m < 4; ++m) { const int row = row0 + ai * HALF + m * 16;
                    f32x4 v0 = acc[ai][bj][m][0] * SC_MLA, v1 = acc[ai][bj][m][1] * SC_MLA;
                    if (isrope) { const int pos = row & seq_mask(row); const f32x4* t = (const f32x4*)(rope + ((size_t)pos * 32 + j0) * 2); const f32x4 c0 = t[0], c1 = t[1];
                        f32x4 o0, o1;
                        o0[0] = v0[0] * c0[0] - v0[1] * c0[1]; o0[1] = v0[0] * c0[1] + v0[1] * c0[0]; o0[2] = v0[2] * c0[2] - v0[3] * c0[3]; o0[3] = v0[2] * c0[3] + v0[3] * c0[2];
                        o1[0] = v1[0] * c1[0] - v1[1] * c1[1]; o1[1] = v1[0] * c1[1] + v1[1] * c1[0]; o1[2] = v1[2] * c1[2] - v1[3] * c1[3]; o1[3] = v1[2] * c1[3] + v1[3] * c1[2];
                        v0 = o0; v1 = o1;
                    }
                    *(u32x4*)(Q + (size_t)row * QW + c8) = pack8(v0, v1); }
        }
    }
};
struct EpiKV {
    bf16* KM; bf16* VM;
    __device__ __forceinline__ void operator()(const f32x4 (&acc)[2][2][4][2], const Unit& u, int wr, int wc, int fr, int fq) const {
        const int row0 = u.pm * BM + wr * 64 + fr, cw = wc * 32 + 8 * fq;
#pragma unroll
        for (int ai = 0; ai < 2; ++ai)
#pragma unroll
            for (int m = 0; m < 4; ++m) { const size_t row = (size_t)(row0 + ai * HALF + m * 16);
                *(u32x4*)(KM + row * QW + u.pn * 192 + cw) = pack8(acc[ai][0][m][0], acc[ai][0][m][1]);
                *(u32x4*)(VM + row * VW + u.pn * 128 + cw) = pack8(acc[ai][1][m][0], acc[ai][1][m][1]); }
    }
};
struct EpiRes {
    float* H; const float* xp; const float* xs;
    __device__ __forceinline__ void operator()(const f32x4 (&acc)[2][2][4][2], const Unit& u, int wr, int wc, int fr, int fq) const {
        const int row0 = u.pm * BM + wr * 64 + fr, col0 = u.pn * BM + wc * 32 + 8 * fq;
        const float* S = xp ? (u.pm * BM < MP ? xp : xs - (size_t)MP * DM) : (const float*)H;
#pragma unroll
        for (int ai = 0; ai < 2; ++ai)
#pragma unroll
            for (int m = 0; m < 4; ++m) { const size_t off = (size_t)(row0 + ai * HALF + m * 16) * DM + col0;
#pragma unroll
                for (int bj = 0; bj < 2; ++bj) { const f32x4* q = (const f32x4*)(S + off + bj * HALF); f32x4* p = (f32x4*)(H + off + bj * HALF); const f32x4 h0 = q[0], h1 = q[1]; p[0] = h0 + acc[ai][bj][m][0]; p[1] = h1 + acc[ai][bj][m][1]; } }
    }
};
struct EpiPlg {
    float* H; const bf16* PL;
    __device__ __forceinline__ void operator()(const f32x4 (&acc)[2][2][4][2], const Unit& u, int wr, int wc, int fr, int fq) const {
        const int row0 = u.pm * BM + wr * 64 + fr, col0 = u.pn * BM + wc * 32 + 8 * fq;
#pragma unroll
        for (int ai = 0; ai < 2; ++ai)
#pragma unroll
            for (int m = 0; m < 4; ++m) { const size_t off = (size_t)(row0 + ai * HALF + m * 16) * DM + col0;
#pragma unroll
                for (int bj = 0; bj < 2; ++bj) { f32x4* p = (f32x4*)(H + off + bj * HALF); const u32x4 e = *(const u32x4*)(PL + off + bj * HALF);
                    const f32x4 a0 = acc[ai][bj][m][0], a1 = acc[ai][bj][m][1]; f32x4 h0 = p[0], h1 = p[1];
                    h0[0] += bf_lo(e.x) * sigmoidf_(a0[0]); h0[1] += bf_hi(e.x) * sigmoidf_(a0[1]); h0[2] += bf_lo(e.y) * sigmoidf_(a0[2]); h0[3] += bf_hi(e.y) * sigmoidf_(a0[3]);
                    h1[0] += bf_lo(e.z) * sigmoidf_(a1[0]); h1[1] += bf_hi(e.z) * sigmoidf_(a1[1]); h1[2] += bf_lo(e.w) * sigmoidf_(a1[2]); h1[3] += bf_hi(e.w) * sigmoidf_(a1[3]);
                    p[0] = h0; p[1] = h1; } }
    }
};
struct EpiGU {
    bf16* ACT; const float* cw; const float* cb;
    __device__ __forceinline__ void operator()(const f32x4 (&acc)[2][2][4][2], const Unit& u, int wr, int wc, int fr, int fq) const {
        const int lane = fr + 16 * fq;
        const int t0 = u.pm * GU_TOK - 1 + 126 * wr + 8 * fr;
        const int f0 = u.pn * 128 + wc * 32 + 8 * fq;
        bool first[8], last[8];
#pragma unroll
        for (int k = 0; k < 8; ++k) { const int t = t0 + k, mk = seq_mask(t); first[k] = (t & mk) == 0; last[k] = ((t + 1) & mk) == 0; }
        unsigned outw[8][4];
#pragma unroll
        for (int n = 0; n < 2; ++n) {
            const f32x4 w0 = *(const f32x4*)(cw + f0 + 4 * n), w1 = *(const f32x4*)(cw + DFF + f0 + 4 * n), w2 = *(const f32x4*)(cw + 2 * DFF + f0 + 4 * n), bb = *(const f32x4*)(cb + f0 + 4 * n);
            float res[8][4];
#pragma unroll
            for (int e = 0; e < 4; ++e) {
                float gv[10];
#pragma unroll
                for (int k = 0; k < 8; ++k) gv[k + 1] = acc[k >> 2][0][k & 3][n][e];
                gv[0] = lane_read(gv[8], (lane + 63) & 63); gv[9] = lane_read(gv[1], (lane + 1) & 63);
#pragma unroll
                for (int k = 0; k < 8; ++k) {
                    float c = __builtin_fmaf(w1[e], gv[k + 1], bb[e]);
                    c += first[k] ? 0.f : w0[e] * gv[k];
                    c += last[k] ? 0.f : w2[e] * gv[k + 2];
                    res[k][e] = gelu_tanh(c) * acc[k >> 2][1][k & 3][n][e];
                }
            }
#pragma unroll
            for (int k = 0; k < 8; ++k) { outw[k][2 * n] = cvt_pk_bf16(res[k][0], res[k][1]); outw[k][2 * n + 1] = cvt_pk_bf16(res[k][2], res[k][3]); }
        }
#pragma unroll
        for (int k = 0; k < 8; ++k) { const int t = t0 + k;
            const bool ok = !(fr == 0 && k == 0) && !(fr == 15 && k == 7) && t < M;
            if (ok) { u32x4 w; w.x = outw[k][0]; w.y = outw[k][1]; w.z = outw[k][2]; w.w = outw[k][3]; *(u32x4*)(ACT + (size_t)t * DFF + f0) = w; } }
    }
};
}

namespace att {
constexpr int NW = 8, QBLK = 32, KVBLK = 64, DV = 128;
constexpr int SHM_V = KVBLK * DV * 2;
constexpr int OFF_V = 0, OFF_K = 3 * SHM_V, OFF_WS = 122880, OFF_TAB = 124928, ATT_LDS = 126976;
constexpr float THR2 = 11.5f;
constexpr float NEG_BIG = -1e30f;
__device__ __forceinline__ int crow(int r, int hi) { return (r & 3) + 8 * (r >> 2) + 4 * hi; }
__device__ __forceinline__ int v_st(int k, int c) { const int kk = (k & ~0xC) | ((k & 4) << 1) | ((k & 8) >> 1); return ((kk >> 3) * 4 + (c >> 5)) * 512 + ((kk & 7) * 32 + (c & 31)) * 2; }
__device__ __forceinline__ int v_rd_base(int lane) { return ((lane & 3) << 3) | (((lane >> 2) & 3) << 6) | (((lane >> 4) & 1) << 5) | (((lane >> 5) & 1) << 8); }
constexpr int v_rd_off(int d0, int ks, int half) { return d0 * 512 + ks * 4096 + half * 2048; }
template <int OFF> __device__ __forceinline__ s16x4 tr_read(int vb) {
    s16x4 r; asm volatile("ds_read_b64_tr_b16 %0, %1 offset:%2" : "=&v"(r) : "v"(vb), "i"(OFF) : "memory"); return r;
}
template <int D0> __device__ __forceinline__ void pv_one(f32x16& od, int vb, bf16x8 pa0, bf16x8 pa1, bf16x8 pa2, bf16x8 pa3) {
    s16x4 l0 = tr_read<v_rd_off(D0, 0, 0)>(vb), h0 = tr_read<v_rd_off(D0, 0, 1)>(vb), l1 = tr_read<v_rd_off(D0, 1, 0)>(vb), h1 = tr_read<v_rd_off(D0, 1, 1)>(vb);
    s16x4 l2 = tr_read<v_rd_off(D0, 2, 0)>(vb), h2 = tr_read<v_rd_off(D0, 2, 1)>(vb), l3 = tr_read<v_rd_off(D0, 3, 0)>(vb), h3 = tr_read<v_rd_off(D0, 3, 1)>(vb);
    asm volatile("s_waitcnt lgkmcnt(0)" : "+v"(l0), "+v"(h0), "+v"(l1), "+v"(h1), "+v"(l2), "+v"(h2), "+v"(l3), "+v"(h3) :: "memory");
#define PK(L, H) (bf16x8){L[0], L[1], L[2], L[3], H[0], H[1], H[2], H[3]}
    od = __builtin_amdgcn_mfma_f32_32x32x16_bf16(pa0, PK(l0, h0), od, 0, 0, 0);
    od = __builtin_amdgcn_mfma_f32_32x32x16_bf16(pa1, PK(l1, h1), od, 0, 0, 0);
    od = __builtin_amdgcn_mfma_f32_32x32x16_bf16(pa2, PK(l2, h2), od, 0, 0, 0);
    od = __builtin_amdgcn_mfma_f32_32x32x16_bf16(pa3, PK(l3, h3), od, 0, 0, 0);
#undef PK
}
__device__ __forceinline__ void pv_d0(f32x16* o, int vb, bf16x8 pa0, bf16x8 pa1, bf16x8 pa2, bf16x8 pa3) {
    pv_one<0>(o[0], vb, pa0, pa1, pa2, pa3); pv_one<1>(o[1], vb, pa0, pa1, pa2, pa3); pv_one<2>(o[2], vb, pa0, pa1, pa2, pa3); pv_one<3>(o[3], vb, pa0, pa1, pa2, pa3);
}
template <int D0> __device__ __forceinline__ void v_frags(int vb, s16x4 (&f)[8]) {
    f[0] = tr_read<v_rd_off(D0, 0, 0)>(vb); f[1] = tr_read<v_rd_off(D0, 0, 1)>(vb); f[2] = tr_read<v_rd_off(D0, 1, 0)>(vb); f[3] = tr_read<v_rd_off(D0, 1, 1)>(vb);
    f[4] = tr_read<v_rd_off(D0, 2, 0)>(vb); f[5] = tr_read<v_rd_off(D0, 2, 1)>(vb); f[6] = tr_read<v_rd_off(D0, 3, 0)>(vb); f[7] = tr_read<v_rd_off(D0, 3, 1)>(vb);
}
__device__ __forceinline__ void v_mma(f32x16& od, s16x4 (&f)[8], bf16x8 pa0, bf16x8 pa1, bf16x8 pa2, bf16x8 pa3) {
    asm volatile("s_waitcnt lgkmcnt(0)" : "+v"(f[0]), "+v"(f[1]), "+v"(f[2]), "+v"(f[3]), "+v"(f[4]), "+v"(f[5]), "+v"(f[6]), "+v"(f[7]) :: "memory");
#define PK(L, H) (bf16x8){L[0], L[1], L[2], L[3], H[0], H[1], H[2], H[3]}
    od = __builtin_amdgcn_mfma_f32_32x32x16_bf16(pa0, PK(f[0], f[1]), od, 0, 0, 0);
    od = __builtin_amdgcn_mfma_f32_32x32x16_bf16(pa1, PK(f[2], f[3]), od, 0, 0, 0);
    od = __builtin_amdgcn_mfma_f32_32x32x16_bf16(pa2, PK(f[4], f[5]), od, 0, 0, 0);
    od = __builtin_amdgcn_mfma_f32_32x32x16_bf16(pa3, PK(f[6], f[7]), od, 0, 0, 0);
#undef PK
}
struct Hook {
    float dl, nslope, sref;
    int tq0;
    int rs, qgr, kr0, relbase, lo;
    const LAS float* tab;
};
template <int MODE>
__device__ __forceinline__ void score_hook(f32x16& p0, f32x16& p1, int j, const Hook& H) {
    if constexpr (MODE == 1) {
        const float t0 = H.dl - (float)(64 * j);
        const int tq = H.tq0 - 64 * j;
        if (tq >= 63 || tq <= -31) {
            const float sn = tq > 0 ? H.nslope : -H.nslope;
#pragma unroll
            for (int r = 0; r < 16; ++r) { const float cr = (float)((r & 3) + 8 * (r >> 2));
                p0[r] = __builtin_fmaf(t0 - cr, sn, p0[r]);
                p1[r] = __builtin_fmaf(t0 - 32.f - cr, sn, p1[r]); }
        } else {
#pragma unroll
            for (int r = 0; r < 16; ++r) { const float cr = (float)((r & 3) + 8 * (r >> 2));
                p0[r] = __builtin_fmaf(__builtin_fabsf(t0 - cr), H.nslope, p0[r]);
                p1[r] = __builtin_fmaf(__builtin_fabsf(t0 - 32.f - cr), H.nslope, p1[r]); } }
    } else if constexpr (MODE == 2) {
        const int kr = H.kr0 + j; const bool rowok = __builtin_amdgcn_readfirstlane((int)((unsigned)(kr - H.rs) < 8u)) != 0;
        if (!rowok) {
#pragma unroll
            for (int r = 0; r < 16; ++r) { p0[r] = NEG_BIG; p1[r] = NEG_BIG; }
            return; }
        int trow = kr - H.qgr + 7; trow = trow < 0 ? 0 : (trow > 14 ? 14 : trow);
        int rb = H.relbase; asm volatile("" : "+v"(rb));
        const LAS float* tr = H.tab + (trow * 16 + H.lo) * 18;
#pragma unroll
        for (int r = 0; r < 16; ++r) { const int cr = (r & 3) + 8 * (r >> 2);
            { int e = rb + cr; e = e < 0 ? 0 : (e > 17 ? 17 : e); p0[r] += tr[e]; }
            { int e = rb + cr + 32; e = e < 0 ? 0 : (e > 17 ? 17 : e); p1[r] += tr[e]; } }
    }
}
template <int MODE>
__device__ __forceinline__ void partialSM(f32x16& p0, f32x16& p1, float& m_reg, float& mn, float& alpha, int j, const Hook& H) {
    score_hook<MODE>(p0, p1, j, H);
    float pmax = p0[0];
#pragma unroll
    for (int r = 1; r < 16; ++r) pmax = fmaxf(pmax, p0[r]);
#pragma unroll
    for (int r = 0; r < 16; ++r) pmax = fmaxf(pmax, p1[r]);
    pmax = xhalf_max(pmax);
    if (__builtin_expect(__all(pmax - m_reg <= THR2), 1)) { mn = m_reg; alpha = 1.f; }
    else { mn = fmaxf(m_reg, pmax); alpha = __builtin_amdgcn_exp2f(m_reg - mn); m_reg = mn; }
#pragma unroll
    for (int r = 0; r < 16; ++r) p0[r] = p0[r] - mn;
#pragma unroll
    for (int r = 0; r < 16; ++r) p1[r] = p1[r] - mn;
}
__device__ __forceinline__ void finishSM(f32x16& p0, f32x16& p1, float alpha, float& l_reg, bf16x8& pa0, bf16x8& pa1, bf16x8& pa2, bf16x8& pa3) {
#pragma unroll
    for (int r = 0; r < 16; ++r) p0[r] = __builtin_amdgcn_exp2f(p0[r]);
#pragma unroll
    for (int r = 0; r < 16; ++r) p1[r] = __builtin_amdgcn_exp2f(p1[r]);
    float ps = 0;
#pragma unroll
    for (int r = 0; r < 16; ++r) ps += p0[r];
#pragma unroll
    for (int r = 0; r < 16; ++r) ps += p1[r];
    ps = xhalf_sum(ps);
    l_reg = l_reg * alpha + ps;
#define PK4(P, BASE, OUT) do { unsigned a0 = cvt_pk_bf16(P[BASE + 0], P[BASE + 1]), a1 = cvt_pk_bf16(P[BASE + 2], P[BASE + 3]);   \
    unsigned b0 = cvt_pk_bf16(P[BASE + 4], P[BASE + 5]), b1 = cvt_pk_bf16(P[BASE + 6], P[BASE + 7]);                              \
    auto r0 = __builtin_amdgcn_permlane32_swap(a0, b0, false, false); auto r1 = __builtin_amdgcn_permlane32_swap(a1, b1, false, false); \
    u32x4 w = {r0[0], r1[0], r0[1], r1[1]}; OUT = *reinterpret_cast<bf16x8*>(&w); } while (0)
    PK4(p0, 0, pa0); PK4(p0, 8, pa1); PK4(p1, 0, pa2); PK4(p1, 8, pa3);
#undef PK4
}
template <int DQK> __device__ __forceinline__ int kswz(int row) { return DQK == 128 ? (row & 15) : ((row >> 1) & 7); }
template <int DQK> constexpr int KNB = DQK == 128 ? 8 : 4;
template <int DQK> __device__ __forceinline__ void k_offsets(int (&kofs)[KNB<DQK>], int r32, int hi) {
#pragma unroll
    for (int i = 0; i < KNB<DQK>; ++i) kofs[i] = r32 * (DQK * 2) + ((i * 32 + hi * 16) ^ (kswz<DQK>(r32) << 4));
}
template <int DQK> __device__ __forceinline__ void k_first(bf16x8& k0, bf16x8& k1, const char* Ks, const int (&kofs)[KNB<DQK>]) {
    k0 = *reinterpret_cast<const bf16x8*>(Ks + kofs[0]); k1 = *reinterpret_cast<const bf16x8*>(Ks + kofs[0] + 32 * (DQK * 2)); }
template <int DQK, bool CINIT>
__device__ __forceinline__ void qkt(f32x16& p0, f32x16& p1, const char* Ks, const int (&kofs)[KNB<DQK>], const bf16x8* qr, bf16x8 k0, bf16x8 k1, const f32x16& nm) {
    if constexpr (CINIT) { p0 = __builtin_amdgcn_mfma_f32_32x32x16_bf16(k0, qr[0], nm, 0, 0, 0); p1 = __builtin_amdgcn_mfma_f32_32x32x16_bf16(k1, qr[0], nm, 0, 0, 0); }
    else { p0 = __builtin_amdgcn_mfma_f32_32x32x16_bf16(k0, qr[0], f32x16{}, 0, 0, 0); p1 = __builtin_amdgcn_mfma_f32_32x32x16_bf16(k1, qr[0], f32x16{}, 0, 0, 0); }
    SBAR();
#pragma unroll
    for (int d0 = 1; d0 < DQK / 16; ++d0) {
        const char* kp = DQK == 128 ? Ks + (kofs[0] ^ (d0 << 5)) : Ks + kofs[d0 % KNB<DQK>] + (d0 / KNB<DQK>) * (KNB<DQK> * 32);
        bf16x8 b0 = *reinterpret_cast<const bf16x8*>(kp);
        bf16x8 b1 = *reinterpret_cast<const bf16x8*>(kp + 32 * (DQK * 2));
        p0 = __builtin_amdgcn_mfma_f32_32x32x16_bf16(b0, qr[d0], p0, 0, 0, 0);
        p1 = __builtin_amdgcn_mfma_f32_32x32x16_bf16(b1, qr[d0], p1, 0, 0, 0); }
}
template <int MODE>
__device__ __forceinline__ void partialSM_relA(f32x16& p0, f32x16& p1, float& delta, bool& shifted, float& alpha, bool& rare, int j, const Hook& H) {
    score_hook<MODE>(p0, p1, j, H);
    float pmax = p0[0];
#pragma unroll
    for (int r = 1; r < 16; ++r) pmax = fmaxf(pmax, p0[r]);
#pragma unroll
    for (int r = 0; r < 16; ++r) pmax = fmaxf(pmax, p1[r]);
    pmax = xhalf_max(pmax) - delta;
    rare = !__all(pmax <= THR2);
    const float d = rare ? fmaxf(pmax, 0.f) : 0.f;
    alpha = __builtin_amdgcn_exp2f(-d); delta += d; shifted = shifted || rare;
}
__device__ __forceinline__ void partialSM_relB(f32x16& p0, f32x16& p1, float delta, bool shifted, float alpha, bool rare, f32x16* o, float* al_l) {
    if (__builtin_expect(shifted, 0)) {
        if (rare) {
            const int ln = lane_now(), hi = ln >> 5; if (hi == 0) al_l[ln] = alpha; asm volatile("s_waitcnt lgkmcnt(0)" ::: "memory");
#pragma unroll
            for (int dd = 0; dd < 4; ++dd)
#pragma unroll
                for (int r = 0; r < 16; ++r) o[dd][r] *= al_l[crow(r, hi)];
        }
#pragma unroll
        for (int r = 0; r < 16; ++r) { p0[r] -= delta; p1[r] -= delta; }
    }
}
__device__ __forceinline__ void store_o(float* p, float v) { *p = v; }
__device__ __forceinline__ void store_o(bf16* p, float v) { *p = (bf16)f2bf(v); }

__device__ __forceinline__ void glds16(const void* gsrc, unsigned lds_dst) { unsigned keep;
    asm volatile("s_mov_b32 %0, m0\n\ts_mov_b32 m0, %2\n\ts_nop 0\n\tglobal_load_lds_dwordx4 %1, off\n\ts_mov_b32 m0, %0" : "=&s"(keep) : "v"(gsrc), "s"(lds_dst) : "memory"); }
#define ATT_WAIT_BAR(N) asm volatile("s_waitcnt vmcnt(%0) lgkmcnt(0)\n\ts_barrier" :: "n"(N) : "memory")
#define ATT_BAR() asm volatile("s_waitcnt lgkmcnt(0)\n\ts_barrier" ::: "memory")

template <int DQK, int MODE, int LDQ, int LDK, int LDV, int LDO, typename TO>
__device__ __forceinline__ void attn_body(const bf16* __restrict__ Qb, const bf16* __restrict__ Kh, const bf16* __restrict__ Vh, TO* __restrict__ Ob, int NT, const Hook& H, char* lds, int wv) {
    constexpr int SHM_K = KVBLK * DQK * 2, KC = DQK / 64, UPR = DQK / 8, NLD = KC + 2;
    const int tid = opaque_tid(wv), wid = __builtin_amdgcn_readfirstlane(tid >> 6), lane = tid & 63, r32 = lane & 31, hi = lane >> 5;
    char* V_lds = lds + OFF_V; char* K_lds = lds + OFF_K;
    float* ws = (float*)(lds + OFF_WS) + wid * 64; float* li_l = ws; float* al_l = ws + 32;
    float m_reg = MODE == 1 ? H.sref : NEG_BIG, l_reg = 0; f32x16 o[4] = {}; bf16x8 qr[DQK / 16];
    const bf16* Qw = Qb + (long)(wid * QBLK + r32) * LDQ + hi * 8;
#pragma unroll
    for (int d0 = 0; d0 < DQK / 16; ++d0) qr[d0] = *reinterpret_cast<const bf16x8*>(Qw + d0 * 16);
    unsigned koff[KC], voff[2];
#pragma unroll
    for (int c = 0; c < KC; ++c) { const int U = 64 * (8 * c + wid) + lane, row = U / UPR, cu = U - row * UPR, q8 = cu ^ kswz<DQK>(row); koff[c] = (unsigned)(row * LDK + q8 * 8) * 2u; }
#pragma unroll
    for (int c = 0; c < 2; ++c) { const int U = 64 * (8 * c + wid) + lane, sub = U >> 5, kk = (sub >> 2) * 8 + ((U >> 2) & 7), k = (kk & ~0xC) | ((kk & 4) << 1) | ((kk & 8) >> 1), col = (sub & 3) * 32 + (U & 3) * 8;
        voff[c] = (unsigned)(k * LDV + col) * 2u; }
    const unsigned ldsK = (unsigned)(uintptr_t)K_lds + (unsigned)wid * 1024u, ldsV = (unsigned)(uintptr_t)V_lds + (unsigned)wid * 1024u;
    const int vb0 = (int)(uintptr_t)V_lds + v_rd_base(lane);
    int kofs[KNB<DQK>]; k_offsets<DQK>(kofs, r32, hi);
#define DMA(t, b) do { const char* _kg = (const char*)Kh + (size_t)(t) * (KVBLK * LDK * 2); const char* _vg = (const char*)Vh + (size_t)(t) * (KVBLK * LDV * 2); \
    _Pragma("unroll") for (int _c = 0; _c < KC; ++_c) glds16(_kg + koff[_c], (unsigned)__builtin_amdgcn_readfirstlane(ldsK + (b) * SHM_K + _c * 8192)); \
    _Pragma("unroll") for (int _c = 0; _c < 2; ++_c) glds16(_vg + voff[_c], (unsigned)__builtin_amdgcn_readfirstlane(ldsV + (b) * SHM_V + _c * 8192)); } while (0)
#define RESC_IF(c, a) do { if (c) { const int _ln = lane_now(), _hi = _ln >> 5; if (_hi == 0) al_l[_ln] = (a); asm volatile("s_waitcnt lgkmcnt(0)" ::: "memory"); \
    _Pragma("unroll") for (int d = 0; d < 4; ++d) _Pragma("unroll") for (int r = 0; r < 16; ++r) o[d][r] *= al_l[crow(r, _hi)]; } } while (0)
    f32x16 pA0, pA1, pB0, pB1; float mnA, mnB, alA, alB; bf16x8 pa0, pa1, pa2, pa3;
    DMA(0, 0); DMA(1, 1);
    ATT_WAIT_BAR(NLD);
    const int rs_u = MODE == 2 ? __builtin_amdgcn_readfirstlane(H.rs - H.kr0) : 0;
#define VOK(t) (MODE != 2 || (unsigned)((t) - rs_u) < 8u)
    f32x16 nm = {}; bf16x8 kf0, kf1;
    k_first<DQK>(kf0, kf1, K_lds, kofs);
    if (VOK(0)) { qkt<DQK, false>(pA0, pA1, K_lds, kofs, qr, kf0, kf1, nm); partialSM<MODE>(pA0, pA1, m_reg, mnA, alA, 0, H); }
    float delta = 0.f; bool shifted = false;
    if constexpr (MODE != 2) {
#pragma unroll
        for (int r = 0; r < 16; ++r) nm[r] = -m_reg; }
#define QKT(P0, P1, KS) qkt<DQK, MODE != 2>(P0, P1, KS, kofs, qr, kf0, kf1, nm)
#define PVPSM(VB, P0, P1, MN, AL, J) do { if constexpr (MODE != 2) { bool _rare; const int _vb = (VB); s16x4 _f3[8]; \
            pv_one<0>(o[0], _vb, pa0, pa1, pa2, pa3); pv_one<1>(o[1], _vb, pa0, pa1, pa2, pa3); pv_one<2>(o[2], _vb, pa0, pa1, pa2, pa3); \
            v_frags<3>(_vb, _f3); partialSM_relA<MODE>(P0, P1, delta, shifted, AL, _rare, J, H); \
            v_mma(o[3], _f3, pa0, pa1, pa2, pa3); \
            partialSM_relB(P0, P1, delta, shifted, AL, _rare, o, al_l); } \
        else { if (VOK((J) - 1)) pv_d0(o, (VB), pa0, pa1, pa2, pa3); if (VOK(J)) { partialSM<MODE>(P0, P1, m_reg, MN, AL, J, H); RESC_IF(__any((AL) < 1.f), AL); } } } while (0)
    ATT_WAIT_BAR(0);
    k_first<DQK>(kf0, kf1, K_lds + SHM_K, kofs);
    if (2 < NT) DMA(2, 2);
    int bp = 0, bc = 1, bn = 2;
    for (int j = 1; j + 1 < NT; j += 2) {
        if (VOK(j)) QKT(pB0, pB1, K_lds + bc * SHM_K);
        if (VOK(j - 1)) finishSM(pA0, pA1, alA, l_reg, pa0, pa1, pa2, pa3);
        PVPSM(vb0 + bp * SHM_V, pB0, pB1, mnB, alB, j);
        ATT_WAIT_BAR(0);
        k_first<DQK>(kf0, kf1, K_lds + bn * SHM_K, kofs);
        DMA(j + 2, bp);
        { const int t = bp; bp = bc; bc = bn; bn = t; }
        if (VOK(j + 1)) QKT(pA0, pA1, K_lds + bc * SHM_K);
        if (VOK(j)) finishSM(pB0, pB1, alB, l_reg, pa0, pa1, pa2, pa3);
        PVPSM(vb0 + bp * SHM_V, pA0, pA1, mnA, alA, j + 1);
        ATT_WAIT_BAR(0);
        k_first<DQK>(kf0, kf1, K_lds + bn * SHM_K, kofs);
        if (j + 3 < NT) DMA(j + 3, bp);
        { const int t = bp; bp = bc; bc = bn; bn = t; }
    }
    SBAR(); if (VOK(NT - 1)) QKT(pB0, pB1, K_lds + bc * SHM_K);
    if (VOK(NT - 2)) finishSM(pA0, pA1, alA, l_reg, pa0, pa1, pa2, pa3); SBAR();
    PVPSM(vb0 + bp * SHM_V, pB0, pB1, mnB, alB, NT - 1);
    if (VOK(NT - 1)) { finishSM(pB0, pB1, alB, l_reg, pa0, pa1, pa2, pa3); SBAR();
        pv_d0(o, vb0 + bc * SHM_V, pa0, pa1, pa2, pa3); }
    const int ln2 = lane_now(), r32e = ln2 & 31, hie = ln2 >> 5;
    if (hie == 0) li_l[r32e] = l_reg; asm volatile("s_waitcnt lgkmcnt(0)" ::: "memory");
    float rli[16];
#pragma unroll
    for (int r = 0; r < 16; ++r) rli[r] = __builtin_amdgcn_rcpf(li_l[crow(r, hie)]);
    TO* Ow = Ob + (long)(wid * QBLK) * LDO;
    if constexpr (sizeof(TO) == 2) {
        constexpr int RS = 272;
        ATT_BAR();
        char* st = lds + wid * (QBLK * RS);
#pragma unroll
        for (int r = 0; r < 16; ++r) { const int orow = crow(r, hie);
#pragma unroll
            for (int d0 = 0; d0 < 4; ++d0) *(bf16*)(st + orow * RS + (d0 * 32 + r32e) * 2) = (bf16)f2bf(o[d0][r] * rli[r]); }
        asm volatile("s_waitcnt lgkmcnt(0)" ::: "memory");
#pragma unroll
        for (int k = 0; k < 8; ++k) { const int row = (ln2 >> 4) + 4 * k, c8 = ln2 & 15;
            const u32x4 w = *(const u32x4*)(st + row * RS + c8 * 16);
            *(u32x4*)((bf16*)Ow + (long)row * LDO + c8 * 8) = w; }
    } else {
#pragma unroll
        for (int r = 0; r < 16; ++r) { const int orow = crow(r, hie);
#pragma unroll
            for (int d0 = 0; d0 < 4; ++d0) store_o(Ow + (long)orow * LDO + d0 * 32 + r32e, o[d0][r] * rli[r]); }
    }
#undef DMA
#undef RESC_IF
#undef QKT
#undef PVPSM
#undef VOK
}
}

#define XB_TMO      128
#define XB_XCNT(j)  (256  + 64 * (j))
#define XB_XSUB(j)  (1280 + 64 * (j))
#define XB_XGEN(j)  (2304 + 64 * (j))
#define XB_TOP      3328
#define XB_TOPGEN   3392
#define XCD_BAR_WORDS 3456
#define XB_SPIN_CAP (1u << 22)
__device__ __forceinline__ unsigned xb_ld(unsigned* p)              { return __hip_atomic_load(p, __ATOMIC_RELAXED, __HIP_MEMORY_SCOPE_AGENT); }
__device__ __forceinline__ unsigned xb_add(unsigned* p, unsigned v) { return __hip_atomic_fetch_add(p, v, __ATOMIC_RELAXED, __HIP_MEMORY_SCOPE_AGENT); }
__device__ __forceinline__ unsigned xb_xcc_id() { return (unsigned)__builtin_amdgcn_s_getreg((3 << 11) | 20) & 0xFu; }
#define XB_SPIN(cond, bar) do { unsigned _sp = 0; while (cond) { __builtin_amdgcn_s_sleep(1); \
    if ((++_sp & 255u) == 0u) { if (xb_ld(&(bar)[XB_TMO])) break; if (_sp > XB_SPIN_CAP) { atomicAdd(&(bar)[XB_TMO], 1u); break; } } } } while (0)
struct XcdBarrier { unsigned* bar; unsigned x; volatile LAS unsigned* st; int wv; };
__device__ __forceinline__ XcdBarrier xcd_barrier_post(unsigned* bar, volatile LAS unsigned* st, int wv) {
    XcdBarrier b; b.bar = bar; b.x = xb_xcc_id(); b.st = st; b.wv = wv;
    if (opaque_tid(wv) == 0) (void)xb_add(&bar[XB_XCNT(b.x)], 1u);
    return b;
}
__device__ __forceinline__ void xcd_barrier_complete(unsigned* bar, unsigned x, unsigned& nloc, unsigned& nx) {
    const unsigned G = gridDim.x * gridDim.y * gridDim.z;
    unsigned sum, cnt, mine, sp = 0u;
    for (;;) {
        sum = 0u; cnt = 0u; mine = 0u;
#pragma unroll
        for (unsigned j = 0; j < 16; ++j) { const unsigned c = xb_ld(&bar[XB_XCNT(j)]); sum += c; cnt += (c > 0u) ? 1u : 0u; mine = (j == x) ? c : mine; }
        if (sum == G) break;
        __builtin_amdgcn_s_sleep(1);
        if ((++sp & 255u) == 0u) { if (xb_ld(&bar[XB_TMO])) break; if (sp > XB_SPIN_CAP) { atomicAdd(&bar[XB_TMO], 1u); break; } }
    }
    nloc = mine > 0u ? mine : 1u; nx = cnt > 0u ? cnt : 1u;
}
__device__ __forceinline__ void xcd_barrier(const XcdBarrier& b) {
    asm volatile("s_waitcnt vmcnt(0)" ::: "memory");
    __syncthreads();
    if (opaque_tid(b.wv) == 0) {
        unsigned* bar = b.bar;
        __builtin_amdgcn_s_waitcnt(0);
        unsigned nloc = b.st[0], nx = b.st[1];
        if (nloc == 0u) { xcd_barrier_complete(bar, b.x, nloc, nx); b.st[0] = nloc; b.st[1] = nx; }
        const unsigned old = xb_add(&bar[XB_XSUB(b.x)], 1u);
        const unsigned gen = old / nloc;
        if (old + 1u == (gen + 1u) * nloc) {
            __builtin_amdgcn_fence(__ATOMIC_RELEASE, "agent");
            asm volatile("s_waitcnt vmcnt(0)" ::: "memory");
            const unsigned og = xb_add(&bar[XB_TOP], 1u);
            const unsigned tg = og / nx;
            if (og + 1u == (tg + 1u) * nx) xb_add(&bar[XB_TOPGEN], 1u);
            else XB_SPIN(xb_ld(&bar[XB_TOPGEN]) == tg, bar);
            __builtin_amdgcn_fence(__ATOMIC_ACQUIRE, "agent");
            xb_add(&bar[XB_XGEN(b.x)], 1u);
            asm volatile("s_waitcnt vmcnt(0)" ::: "memory");
        } else {
            XB_SPIN(xb_ld(&bar[XB_XGEN(b.x)]) == gen, bar);
            __builtin_amdgcn_fence(__ATOMIC_ACQUIRE, "agent");
            asm volatile("s_waitcnt vmcnt(0)" ::: "memory");
        }
    }
    __syncthreads();
}

template <int MAP> __device__ __forceinline__ int srccol(int n) {
    if constexpr (MAP == 1) { return n < 768 ? n : (n < 3840 ? n + 64 : (n < 3904 ? n - 3840 + 768 : -1)); }
    else if constexpr (MAP == 2) { const int hd = n / 192, cin = n - hd * 192; if (cin < 128) return n; const int t = cin - 128; return hd * 192 + 128 + (t >> 1) + 32 * (t & 1); }
    else if constexpr (MAP == 3) { return ((n >> 7) & 1) * DFF + (n >> 8) * 128 + (n & 127); }
    else return n;
}
template <int MAP>
__device__ __forceinline__ void transpose_item(const float* __restrict__ W, int K, int Nsrc, bf16* __restrict__ WT, LAS float* scr, int item, int nblk, int lane) {
    const int kb = item / nblk, nb = item - kb * nblk, k0 = 64 * kb, n0 = 32 * nb;
    const int scn = srccol<MAP>(n0 + (lane & 31));
    float wv[32];
    const float* wp = W + (size_t)(k0 + (lane >> 5)) * Nsrc + (scn >= 0 ? scn : 0);
#pragma unroll
    for (int i = 0; i < 32; ++i) wv[i] = wp[(size_t)(2 * i) * Nsrc];
#pragma unroll
    for (int i = 0; i < 32; ++i) { const int kk = 2 * i + (lane >> 5); scr[kk * 33 + (lane & 31)] = scn >= 0 ? wv[i] : 0.f; }
    LDS_WAIT(); asm volatile("" ::: "memory");
    const int c = lane & 7;
#pragma unroll
    for (int j = 0; j < 4; ++j) { const int n = (lane >> 3) + 8 * j; const LAS float* s = scr + (8 * c) * 33 + n;
        u32x4 o; o.x = pk2(s[0 * 33], s[1 * 33]); o.y = pk2(s[2 * 33], s[3 * 33]); o.z = pk2(s[4 * 33], s[5 * 33]); o.w = pk2(s[6 * 33], s[7 * 33]);
        *(u32x4*)(WT + (size_t)(n0 + n) * K + k0 + 8 * c) = o; }
    LDS_WAIT(); asm volatile("" ::: "memory");
}
struct Row8 { f32x4 v[8]; };
__device__ __forceinline__ void row_load(Row8& r, const float* src, int lane) {
#pragma unroll
    for (int j = 0; j < 8; ++j) r.v[j] = ((const f32x4*)src)[lane + 64 * j]; }
__device__ __forceinline__ float row_rstd(const Row8& r) { float ss = 0.f;
#pragma unroll
    for (int j = 0; j < 8; ++j) ss += (r.v[j].x * r.v[j].x + r.v[j].y * r.v[j].y) + (r.v[j].z * r.v[j].z + r.v[j].w * r.v[j].w);
    return 1.f / sqrtf(wave_sum(ss) * (1.f / DM) + RMS_EPS); }
__device__ __forceinline__ void norm_fin_bf16(const Row8& r, const float* g, bf16* dst, float* cp, int lane) {
    const float rstd = row_rstd(r);
#pragma unroll
    for (int j = 0; j < 8; ++j) { const f32x4 gg = ((const f32x4*)g)[lane + 64 * j]; const f32x4 v = r.v[j];
        u32x2 w; w.x = pk2(v.x * rstd * gg.x, v.y * rstd * gg.y); w.y = pk2(v.z * rstd * gg.z, v.w * rstd * gg.w);
        ((u32x2*)dst)[lane + 64 * j] = w;
        if (cp) ((f32x4*)cp)[lane + 64 * j] = v; }
}
__device__ __forceinline__ void norm_fin_f32(const Row8& r, const float* g, float* io, int lane) {
    const float rstd = row_rstd(r);
#pragma unroll
    for (int j = 0; j < 8; ++j) { const f32x4 gg = ((const f32x4*)g)[lane + 64 * j]; const f32x4 v = r.v[j]; f32x4 o; o.x = v.x * rstd * gg.x; o.y = v.y * rstd * gg.y; o.z = v.z * rstd * gg.z; o.w = v.w * rstd * gg.w;
        ((f32x4*)io)[lane + 64 * j] = o; }
}
#define ROW_STREAM(SRC, FIN) do { int _m = gw; if (_m < M) { Row8 _ra, _rb; row_load(_ra, SRC(_m), lane); \
    for (;;) { const int _m1 = _m + NGW; row_load(_rb, SRC(_m1 < M ? _m1 : _m), lane); FIN(_ra, _m); if (_m1 >= M) break; \
        const int _m2 = _m1 + NGW; row_load(_ra, SRC(_m2 < M ? _m2 : _m1), lane); FIN(_rb, _m1); if (_m2 >= M) break; _m = _m2; } } } while (0)
__device__ __forceinline__ void unpack8(u32x4 w, float (&f)[8]) { f[0] = bf_lo(w.x); f[1] = bf_hi(w.x); f[2] = bf_lo(w.y); f[3] = bf_hi(w.y); f[4] = bf_lo(w.z); f[5] = bf_hi(w.z); f[6] = bf_lo(w.w); f[7] = bf_hi(w.w); }
__device__ __forceinline__ void postz_row(bf16* __restrict__ z, const float* __restrict__ gq, const float* __restrict__ gkv, const float* __restrict__ rope, bf16* __restrict__ kmrow, int row, int lane, bf16* __restrict__ cqn, bf16* __restrict__ ckvn, float* __restrict__ qn, float* __restrict__ kn, float* __restrict__ sf) {
    { float fq[8], fk[8]; unpack8(*(const u32x4*)(z + Z_DQ + lane * 8), fq); unpack8(*(const u32x4*)(z + Z_DK + lane * 8), fk); float sq = 0.f, sk = 0.f;
#pragma unroll
      for (int e = 0; e < 8; ++e) { sq += fq[e] * fq[e]; sk += fk[e] * fk[e]; }
      sq += swz_xor<1>(sq); sq += swz_xor<2>(sq); sq += swz_xor<4>(sq); sk += swz_xor<1>(sk); sk += swz_xor<2>(sk); sk += swz_xor<4>(sk);
      float sd = 0.f;
#pragma unroll
      for (int e = 0; e < 8; ++e) sd += fq[e] * fk[e];
      sd += swz_xor<1>(sd); sd += swz_xor<2>(sd); sd += swz_xor<4>(sd);
      if ((lane & 7) == 0) { qn[lane >> 3] = sq; kn[lane >> 3] = sk; sf[lane >> 3] = sd; } }
    { const u32x4 w = *(const u32x4*)(z + Z_CQ + lane * 8); float f[8]; unpack8(w, f); float ss = 0.f;
#pragma unroll
      for (int e = 0; e < 8; ++e) ss += f[e] * f[e];
      const float rstd = 1.f / sqrtf(wave_sum(ss) * (1.f / 512.f) + RMS_EPS);
      const f32x4 g0 = *(const f32x4*)(gq + lane * 8), g1 = *(const f32x4*)(gq + lane * 8 + 4);
      u32x4 o; o.x = pk2(f[0] * rstd * g0.x, f[1] * rstd * g0.y); o.y = pk2(f[2] * rstd * g0.z, f[3] * rstd * g0.w); o.z = pk2(f[4] * rstd * g1.x, f[5] * rstd * g1.y); o.w = pk2(f[6] * rstd * g1.z, f[7] * rstd * g1.w);
      *(u32x4*)(cqn + lane * 8) = o; }
    { const int l2 = lane & 31; const u32x4 w = *(const u32x4*)(z + Z_CKV + l2 * 8); float f[8]; unpack8(w, f); float ss = 0.f;
#pragma unroll
      for (int e = 0; e < 8; ++e) ss += f[e] * f[e];
      if (lane >= 32) ss = 0.f;
      const float rstd = 1.f / sqrtf(wave_sum(ss) * (1.f / 256.f) + RMS_EPS);
      const f32x4 g0 = *(const f32x4*)(gkv + l2 * 8), g1 = *(const f32x4*)(gkv + l2 * 8 + 4);
      u32x4 o; o.x = pk2(f[0] * rstd * g0.x, f[1] * rstd * g0.y); o.y = pk2(f[2] * rstd * g0.z, f[3] * rstd * g0.w); o.z = pk2(f[4] * rstd * g1.x, f[5] * rstd * g1.y); o.w = pk2(f[6] * rstd * g1.z, f[7] * rstd * g1.w);
      if (lane < 32) *(u32x4*)(ckvn + l2 * 8) = o; }
    if (lane < 32) { const float x1 = bf_lo((unsigned)z[Z_KPE + lane]), x2 = bf_lo((unsigned)z[Z_KPE + 32 + lane]);
      const int pos = row & seq_mask(row); const f32x2 cs = *(const f32x2*)(rope + ((size_t)pos * 32 + lane) * 2);
      const unsigned w = pk2(x1 * cs.x - x2 * cs.y, x1 * cs.y + x2 * cs.x);
#pragma unroll
      for (int h = 0; h < 8; ++h) *(unsigned*)(kmrow + h * 192 + 128 + 2 * lane) = w; }
}
__device__ __forceinline__ void diffc_row(const float* __restrict__ o1, const float* __restrict__ o2, const float* __restrict__ gs, float lam, float post, bf16* __restrict__ mixrow, int lane) {
    const f32x4 a0 = *(const f32x4*)(o1 + lane * 8), a1 = *(const f32x4*)(o1 + lane * 8 + 4), b0 = *(const f32x4*)(o2 + lane * 8), b1 = *(const f32x4*)(o2 + lane * 8 + 4);
    const f32x4 d0 = a0 - b0 * lam, d1 = a1 - b1 * lam;
    float ss = (d0.x * d0.x + d0.y * d0.y) + (d0.z * d0.z + d0.w * d0.w) + (d1.x * d1.x + d1.y * d1.y) + (d1.z * d1.z + d1.w * d1.w);
    ss = half_sum16(ss);
    const float r = post / sqrtf(ss * (1.f / 128.f) + RMS_EPS);
    const f32x4 g0 = *(const f32x4*)(gs + (lane & 15) * 8), g1 = *(const f32x4*)(gs + (lane & 15) * 8 + 4);
    u32x4 o; o.x = pk2(d0.x * r * g0.x, d0.y * r * g0.y); o.y = pk2(d0.z * r * g0.z, d0.w * r * g0.w); o.z = pk2(d1.x * r * g1.x, d1.y * r * g1.y); o.w = pk2(d1.z * r * g1.z, d1.w * r * g1.w);
    *(u32x4*)(mixrow + 1536 + lane * 8) = o;
}


__device__ const float ROPE_FREQ[32] = {1.000000000e+00f, 7.498942614e-01f, 5.623413324e-01f, 4.216965139e-01f, 3.162277639e-01f, 2.371373773e-01f, 1.778279394e-01f, 1.333521307e-01f, 1.000000015e-01f, 7.498941571e-02f, 5.623413250e-02f, 4.216965288e-02f, 3.162277490e-02f, 2.371373773e-02f, 1.778279431e-02f, 1.333521493e-02f, 9.999999776e-03f, 7.498941850e-03f, 5.623413250e-03f, 4.216964822e-03f, 3.162277630e-03f, 2.371373586e-03f, 1.778279431e-03f, 1.333521446e-03f, 1.000000047e-03f, 7.498942432e-04f, 5.623413017e-04f, 4.216965172e-04f, 3.162277571e-04f, 2.371373703e-04f, 1.778279402e-04f, 1.333521504e-04f};
constexpr int PH_PER_LAYER = 12, N_PHASES = DEPTH * PH_PER_LAYER + 1;
struct Args { const float* in[26]; float* out; unsigned char* ws; int ph_lo, ph_hi, sub, pad; };
enum { I_XP = 0, I_XS, I_PP, I_PS, I_GATTN, I_WIN, I_GQA, I_WQB, I_GKVA, I_WKVB, I_RPB, I_LQ1, I_LK1, I_LQ2, I_LK2, I_GSUB, I_WOUT, I_GFFN, I_WGU, I_CONVW, I_CONVB, I_WDOWN, I_GPLE, I_WPLG, I_WPLE, I_GFINAL };

typedef const __attribute__((address_space(4))) Args* ArgsP;
__device__ __forceinline__ ArgsP site_args() { ArgsP p = (ArgsP)__builtin_amdgcn_kernarg_segment_ptr(); asm volatile("" : "+s"(p)); return p; }
#ifndef PH_MASK
#define PH_MASK 0x1fff
#endif
#ifndef SUB_MASK
#define SUB_MASK 0xff
#endif
#define SUB(k) ((submask >> (k)) & 1)

__global__ void __launch_bounds__(NWAVES * 64, 2) fwd(Args args_unused) {
    extern __shared__ __attribute__((aligned(16))) unsigned char lds_raw[];
    LAS unsigned char* lds = (LAS unsigned char*)lds_raw;
    const int G = gridDim.x; const int bx = blockIdx.x; const int vcu = (G % 8 == 0) ? (bx % 8) * (G / 8) + bx / 8 : bx;
    { const int tid = threadIdx.x; for (int u = tid; u < (LDS_BYTES - RING_BYTES) / 4; u += NWAVES * 64) ((LAS unsigned*)(lds + RING_BYTES))[u] = 0u; }
    __syncthreads();
    const int wave0 = __builtin_amdgcn_readfirstlane((int)threadIdx.x >> 6);
    int lo, hi, submask;
    XcdBarrier bar;
    { ArgsP ap = site_args(); lo = ap->ph_lo; hi = ap->ph_hi; submask = ap->sub; unsigned* ctl = (unsigned*)(ap->ws + WS_CTL);
      bar.bar = ctl + CW_BAR; bar.x = 0; bar.st = (volatile LAS unsigned*)(lds + MISC_OFF) + 8; bar.wv = wave0;
      if (hi - lo > 1) bar = xcd_barrier_post(ctl + CW_BAR, (volatile LAS unsigned*)(lds + MISC_OFF) + 8, wave0); }
#define IN(k) (((PH_MASK >> (((k) >= DEPTH * PH_PER_LAYER) ? 12 : ((k) % PH_PER_LAYER))) & 1) && lo <= (k) && (k) < hi)
#define SEAM(k) do { if (IN(k) && IN((k) + 1)) xcd_barrier(bar); } while (0)
#define SITE() ArgsP ap = site_args(); unsigned char* const ws = ap->ws; const int tid = opaque_tid(wave0), lane = tid & 63, wave = __builtin_amdgcn_readfirstlane(tid >> 6); \
    const int gw = vcu * NWAVES + wave, NGW = G * NWAVES; (void)gw; (void)NGW; (void)lane; (void)ws
#define WSP(T, off) ((T*)(ws + (off)))

    for (int l = 0; l < DEPTH; ++l) {
        const int P0 = l * PH_PER_LAYER;
        if (IN(P0 + 0)) { SITE();
            const int gt = vcu * (NWAVES * 64) + tid, NGT = G * NWAVES * 64;
            LAS float* scr = (LAS float*)(lds + wave * 16384);
            constexpr int I0 = 32 * 128, I1 = I0 + 8 * 48, I2 = I1 + 4 * 64, I3 = I2 + 32 * 64, I4 = I3 + 32 * 352, I5 = I4 + 88 * 64, I6 = I5 + 32 * 64, I7 = I6 + 4 * 64;
            for (int it = gw; it < I7; it += NGW) {
                if (it < I0) transpose_item<1>(ap->in[I_WIN] + (size_t)l * DM * IN_W, DM, IN_W, WSP(bf16, WS_WIN), scr, it, 128, lane);
                else if (it < I1) transpose_item<2>(ap->in[I_WQB] + (size_t)l * 512 * QW, 512, QW, WSP(bf16, WS_WQB), scr, it - I0, 48, lane);
                else if (it < I2) transpose_item<0>(ap->in[I_WKVB] + (size_t)l * 256 * KVW, 256, KVW, WSP(bf16, WS_WKVB), scr, it - I1, 64, lane);
                else if (it < I3) transpose_item<0>(ap->in[I_WOUT] + (size_t)l * DM * DM, DM, DM, WSP(bf16, WS_WOUT), scr, it - I2, 64, lane);
                else if (it < I4) transpose_item<3>(ap->in[I_WGU] + (size_t)l * DM * 2 * DFF, DM, 2 * DFF, WSP(bf16, WS_WGU), scr, it - I3, 352, lane);
                else if (it < I5) transpose_item<0>(ap->in[I_WDOWN] + (size_t)l * DFF * DM, DFF, DM, WSP(bf16, WS_WDOWN), scr, it - I4, 64, lane);
                else if (it < I6) transpose_item<0>(ap->in[I_WPLG] + (size_t)l * DM * DM, DM, DM, WSP(bf16, WS_WPLG), scr, it - I5, 64, lane);
                else transpose_item<0>(ap->in[I_WPLE] + (size_t)l * PLE * DM, PLE, DM, WSP(bf16, WS_WPLE), scr, it - I6, 64, lane);
            }
            { bf16* PB = WSP(bf16, WS_PB); const float* pp = ap->in[I_PP] + (size_t)l * MP * PLE; const float* ps = ap->in[I_PS] + (size_t)l * MS * PLE;
              for (int i = gt; i < M * (PLE / 8); i += NGT) { const int row = i >> 5, c = (i & 31) * 8;
                const float* src = row < MP ? pp + (size_t)row * PLE + c : ps + (size_t)(row - MP) * PLE + c;
                const f32x4 a = *(const f32x4*)src, b = *(const f32x4*)(src + 4);
                u32x4 o; o.x = pk2(a.x, a.y); o.y = pk2(a.z, a.w); o.z = pk2(b.x, b.y); o.w = pk2(b.z, b.w); *(u32x4*)(PB + (size_t)row * PLE + c) = o; } }
            if (l == 0) { float* ROPE = WSP(float, WS_ROPE);
                for (int i = gt; i < LP * 32; i += NGT) { const int pos = i >> 5, j = i & 31;
                    const float freq = ROPE_FREQ[j];
                    const float ang = (float)pos * freq;
                    double rev = (double)ang * 0.15915494309189535; rev -= floor(rev);
                    const float fr = (float)rev;
                    f32x2 cs; cs.x = __builtin_amdgcn_cosf(fr); cs.y = __builtin_amdgcn_sinf(fr); *(f32x2*)(ROPE + (size_t)i * 2) = cs; } }
            { bf16* AB = WSP(bf16, WS_A); float* H = ap->out; const float* g = ap->in[I_GATTN] + l * DM; const float* xp = ap->in[I_XP]; const float* xs = ap->in[I_XS];
#define P0_SRC(m) (l == 0 ? ((m) < MP ? xp + (size_t)(m) * DM : xs + (size_t)((m) - MP) * DM) : (const float*)H + (size_t)(m) * DM)
#define P0_FIN(r, m) norm_fin_bf16(r, g, AB + (size_t)(m) * DM, nullptr, lane)
              ROW_STREAM(P0_SRC, P0_FIN); }
#undef P0_SRC
#undef P0_FIN
        }
        SEAM(P0 + 0);
        if (IN(P0 + 1)) { SITE(); pg8::Gemm g{WSP(bf16, WS_A), WSP(bf16, WS_WIN), DM, DM}; pg8::StaticOrder S; S.init(M / 256, ZLD / 256, G, bx); pg8::EpiZ E{WSP(bf16, WS_Z)};
            pg8::gemm_phase<pg8::EpiZ, false>(lds, g, S, E, wave0); }
        SEAM(P0 + 1);
        if (IN(P0 + 2)) { SITE(); bf16* Z = WSP(bf16, WS_Z); bf16* KM = WSP(bf16, WS_KM); const float* ROPE = WSP(float, WS_ROPE); const float* gq = ap->in[I_GQA] + l * 512; const float* gkv = ap->in[I_GKVA] + l * 256;
            for (int m = gw; m < M; m += NGW) postz_row(Z + (size_t)m * ZLD, gq, gkv, ROPE, KM + (size_t)m * QW, m, lane, WSP(bf16, WS_CQN) + (size_t)m * 512, WSP(bf16, WS_CKVN) + (size_t)m * 256, WSP(float, WS_QN) + (size_t)m * 8, WSP(float, WS_KN) + (size_t)m * 8, WSP(float, WS_SELF) + (size_t)m * 8);
        }
        SEAM(P0 + 2);
        if (IN(P0 + 3)) {
            if (SUB(0)) { SITE(); pg8::Gemm g{WSP(bf16, WS_CKVN), WSP(bf16, WS_WKVB), 256, 256}; pg8::StaticOrder S; S.init(M / 256, KVW / 256, G, bx); pg8::EpiKV E{WSP(bf16, WS_KM), WSP(bf16, WS_VM)}; pg8::gemm_phase<pg8::EpiKV, false>(lds, g, S, E, wave0); }
            if (SUB(1)) { SITE(); pg8::Gemm g{WSP(bf16, WS_CQN), WSP(bf16, WS_WQB), 512, 512}; pg8::StaticOrder S; S.init(M / 256, QW / 256, G, bx); pg8::EpiQ E{WSP(bf16, WS_QM), WSP(float, WS_ROPE)}; pg8::gemm_phase<pg8::EpiQ, false>(lds, g, S, E, wave0); }
        }
        SEAM(P0 + 3);
        if (IN(P0 + 4)) {
            char* alds = (char*)lds_raw;
            if (SUB(2)) { SITE(); const bf16* QM = WSP(bf16, WS_QM); const bf16* KM = WSP(bf16, WS_KM); const bf16* VM = WSP(bf16, WS_VM); bf16* AB = WSP(bf16, WS_A);
              for (int u = vcu; u < 1024 + 512; u += G) {
                int s0, L, h, qb;
                if (u < 1024) { const int bh = u >> 6; qb = u & 63; h = bh & 7; s0 = (bh >> 3) * LP; L = LP; }
                else { const int v = u - 1024, bh = v >> 3; qb = v & 7; h = bh & 7; s0 = MP + (bh >> 3) * LS; L = LS; }
                att::Hook Hk{};
                att::attn_body<192, 0, QW, QW, VW, DM, bf16>(QM + (size_t)(s0 + qb * 256) * QW + h * 192, KM + (size_t)s0 * QW + h * 192, VM + (size_t)s0 * VW + h * 128,
                                                           AB + (size_t)(s0 + qb * 256) * DM + h * 128, L / 64, Hk, alds, wave0);
                __syncthreads();
              } }
            if (SUB(3)) { SITE(); const bf16* Z = WSP(bf16, WS_Z); float* DOB = WSP(float, WS_DO); const float* QN = WSP(float, WS_QN); const float* KN = WSP(float, WS_KN); const float* SF = WSP(float, WS_SELF); const int r32 = lane & 31, hi5 = lane >> 5;
              LAS float* red = (LAS float*)(lds + att::OFF_TAB);
              unsigned* dyn = (unsigned*)(ws + WS_CTL) + CW_DYN + l;
              for (int u = vcu, dynamic = 0;;) {
                if (!dynamic && u >= 1024) dynamic = 1;
                if (dynamic) {
                    if (tid == 0) ((LAS unsigned*)red)[32] = xb_add(dyn, 1u);
                    __syncthreads();
                    const unsigned w = (unsigned)__builtin_amdgcn_readfirstlane((int)((LAS unsigned*)red)[32]);
                    if (w >= 512u) break;
                    u = 1024 + (int)w; }
                int s0, L, h, mp, qb;
                if (u < 1024) { const int r = u >> 8, g = (u >> 6) & 3; qb = u & 63; h = (g + r) & 3; mp = r & 1; s0 = (r >> 1) * LP; L = LP; }
                else { const int v = u - 1024, rem = v & 127; h = 3 - (v >> 7); qb = rem & 7; mp = (rem >> 3) & 1; s0 = MP + (rem >> 4) * LS; L = LS; }
                const int vec = h * 2 + mp, q0 = qb * 256;
                { const int t2 = opaque_tid(wave0); float k2 = 0.f; for (int r = t2; r < L; r += NWAVES * 64) k2 = fmaxf(k2, KN[(size_t)(s0 + r) * 8 + vec]);
                  float q2 = t2 < 256 ? QN[(size_t)(s0 + q0 + t2) * 8 + vec] : 0.f;
                  float ns = t2 < 256 ? -SF[(size_t)(s0 + q0 + t2) * 8 + vec] : -3.0e38f;
                  k2 = wave_max(k2); q2 = wave_max(q2); ns = wave_max(ns);
                  if ((t2 & 63) == 0) { red[t2 >> 6] = k2; red[8 + (t2 >> 6)] = q2; red[16 + (t2 >> 6)] = ns; } }
                __syncthreads();
                float k2 = red[0], q2 = red[8], ns = red[16];
#pragma unroll
                for (int i = 1; i < 8; ++i) { k2 = fmaxf(k2, red[i]); q2 = fmaxf(q2, red[8 + i]); ns = fmaxf(ns, red[16 + i]); }
                const float slope2 = LOG2E * exp2f(-2.f * (float)(h + 1));
                const float dstar = (1.01f * sqrtf(k2 * q2) + ns + 0.05f + 152.f) / slope2;
                const int NTall = L / 64; int tlo = 0, thi = NTall;
                if (dstar < 1.0e6f) { const int D = (int)dstar + 2; tlo = (q0 - D - 63) / 64; tlo = tlo < 0 ? 0 : tlo; thi = (q0 + 255 + D) / 64 + 1; thi = thi > NTall ? NTall : thi; }
                if ((thi - tlo) & 1) { if (thi < NTall) ++thi; else --tlo; }
                tlo = __builtin_amdgcn_readfirstlane(tlo); thi = __builtin_amdgcn_readfirstlane(thi);
                att::Hook Hk{}; Hk.dl = (float)(q0 - 64 * tlo + wave * 32 + r32 - 4 * hi5); Hk.nslope = -slope2; Hk.tq0 = q0 - 64 * tlo + wave * 32; Hk.sref = SF[(size_t)(s0 + q0 + wave * 32 + r32) * 8 + vec];
                att::attn_body<64, 1, ZLD, ZLD, ZLD, 512, float>(Z + (size_t)(s0 + q0) * ZLD + Z_DQ + h * 128 + mp * 64, Z + (size_t)(s0 + 64 * tlo) * ZLD + Z_DK + h * 128 + mp * 64, Z + (size_t)(s0 + 64 * tlo) * ZLD + Z_DV + h * 128,
                                                               DOB + (size_t)mp * M * 512 + (size_t)(s0 + q0) * 512 + h * 128, thi - tlo, Hk, alds, wave0);
                __syncthreads();
                if (!dynamic) u += G;
              } }
            if (SUB(4)) { SITE(); const bf16* Z = WSP(bf16, WS_Z); bf16* AB = WSP(bf16, WS_A); const float* rpb = ap->in[I_RPB] + (size_t)l * 4 * 15 * 31; const int r32 = lane & 31, hi5 = lane >> 5;
              for (int u = vcu; u < (M / 256) * 4; u += G) {
                const int h = u & 3, row0 = (u >> 2) * 256;
                const int L = row0 < MP ? LP : LS, s0 = row0 < MP ? (row0 & ~(LP - 1)) : (MP + ((row0 - MP) & ~(LS - 1)));
                const int rows = L / 64, R0 = (row0 - s0) / 64;
                int tlo = R0 - 4; tlo = tlo < 0 ? 0 : (tlo > rows - 12 ? rows - 12 : tlo);
                LAS float* tab = (LAS float*)(lds + 98304);
                { const int t2 = opaque_tid(wave0);
                  for (int i = t2; i < 15 * 16 * 18; i += NWAVES * 64) { const int e = i % 18, q = i / 18, lo_ = q & 15, tr_ = q >> 4, d = e - 1;
                      tab[i] = (d >= 0 && d < 16) ? rpb[((size_t)h * 15 + tr_) * 31 + d + lo_] * LOG2E : att::NEG_BIG; } }
                __syncthreads();
                att::Hook Hk{}; const int qc = (wave & 1) * 32 + r32; int cs = qc - 8; cs = cs < 0 ? 0 : (cs > 48 ? 48 : cs);
                Hk.relbase = 4 * hi5 - cs + 1; Hk.lo = cs - qc + 15; Hk.qgr = R0 + (wave >> 1); int rs = Hk.qgr - 4; rs = rs < 0 ? 0 : (rs > rows - 8 ? rows - 8 : rs); Hk.rs = rs; Hk.kr0 = tlo; Hk.tab = tab;
                att::attn_body<128, 2, ZLD, ZLD, ZLD, DM, bf16>(Z + (size_t)row0 * ZLD + Z_NAQ + h * 128, Z + (size_t)(s0 + tlo * 64) * ZLD + Z_NAK + h * 128, Z + (size_t)(s0 + tlo * 64) * ZLD + Z_NAV + h * 128,
                                                              AB + (size_t)row0 * DM + 1024 + h * 128, 12, Hk, alds, wave0);
                __syncthreads();
              } }
        }
        SEAM(P0 + 4);
        if (IN(P0 + 5)) { SITE();
            float s1 = ap->in[I_LQ1][l * 64 + lane] * ap->in[I_LK1][l * 64 + lane], s2 = ap->in[I_LQ2][l * 64 + lane] * ap->in[I_LK2][l * 64 + lane];
            s1 = wave_sum(s1); s2 = wave_sum(s2);
            int lq = l; asm volatile("" : "+s"(lq));
            const float lam_init = lq == 0 ? 0.2f : (lq == 1 ? 0.35550906759096926f : (lq == 2 ? 0.47071301834358414f : 0.5560582041556405f));
            const float lam = expf(s1) - expf(s2) + lam_init;
            const float* DOB = WSP(float, WS_DO); bf16* AB = WSP(bf16, WS_A); const float* gs = ap->in[I_GSUB] + l * 128;
            for (int m = gw; m < M; m += NGW) diffc_row(DOB + (size_t)m * 512, DOB + (size_t)M * 512 + (size_t)m * 512, gs, lam, 1.f - lam_init, AB + (size_t)m * DM, lane);
        }
        SEAM(P0 + 5);
        if (IN(P0 + 6)) { SITE(); pg8::Gemm g{WSP(bf16, WS_A), WSP(bf16, WS_WOUT), DM, DM}; pg8::StaticOrder S; S.init(M / 256, DM / 256, G, bx); pg8::EpiRes E{ap->out, l == 0 ? ap->in[I_XP] : nullptr, ap->in[I_XS]}; pg8::gemm_phase<pg8::EpiRes, false>(lds, g, S, E, wave0); }
        SEAM(P0 + 6);
#define HN_SRC(m) (H + (size_t)(m) * DM)
#define HN_FIN(r, m) norm_fin_bf16(r, g, AB + (size_t)(m) * DM, nullptr, lane)
        if (IN(P0 + 7)) { SITE(); const float* H = ap->out; bf16* AB = WSP(bf16, WS_A); const float* g = ap->in[I_GFFN] + l * DM;
            ROW_STREAM(HN_SRC, HN_FIN); }
        SEAM(P0 + 7);
        if (IN(P0 + 8)) { SITE(); pg8::Gemm g{WSP(bf16, WS_A), WSP(bf16, WS_WGU), DM, DM}; pg8::StaticOrder S; S.init(GU_NM, (2 * DFF) / 256, G, bx);
            pg8::EpiGU E{WSP(bf16, WS_ACT), ap->in[I_CONVW] + (size_t)l * 3 * DFF, ap->in[I_CONVB] + (size_t)l * DFF};
            pg8::gemm_phase<pg8::EpiGU, true>(lds, g, S, E, wave0); }
        SEAM(P0 + 8);
        if (IN(P0 + 9)) { SITE(); pg8::Gemm g{WSP(bf16, WS_ACT), WSP(bf16, WS_WDOWN), DFF, DFF}; pg8::StaticOrder S; S.init(M / 256, DM / 256, G, bx); pg8::EpiRes E{ap->out, nullptr, nullptr}; pg8::gemm_phase<pg8::EpiRes, false>(lds, g, S, E, wave0); }
        SEAM(P0 + 9);
        if (IN(P0 + 10)) {
            const int NORM_WG = (G == 256 && submask == 0xff) ? 120 : 0;
            if (NORM_WG == 0) {
                if (SUB(5)) { SITE(); const float* H = ap->out; bf16* AB = WSP(bf16, WS_A); const float* g = ap->in[I_GPLE] + l * DM;
                    ROW_STREAM(HN_SRC, HN_FIN); }
                __syncthreads();
                if (SUB(6)) { SITE(); pg8::Gemm g{WSP(bf16, WS_PB), WSP(bf16, WS_WPLE), PLE, PLE}; pg8::StaticOrder S; S.init(M / 256, DM / 256, G, bx); pg8::EpiStore E{WSP(bf16, WS_PLEB), DM}; pg8::gemm_phase<pg8::EpiStore, false>(lds, g, S, E, wave0); }
            } else if (bx < NORM_WG) { SITE(); const float* H = ap->out; bf16* AB = WSP(bf16, WS_A); const float* g = ap->in[I_GPLE] + l * DM;
                { const int gw = bx * NWAVES + wave, NGW = NORM_WG * NWAVES; ROW_STREAM(HN_SRC, HN_FIN); }
            } else { SITE(); pg8::Gemm g{WSP(bf16, WS_PB), WSP(bf16, WS_WPLE), PLE, PLE}; pg8::StaticOrder S; S.init(M / 256, DM / 256, G - NORM_WG, bx - NORM_WG); pg8::EpiStore E{WSP(bf16, WS_PLEB), DM}; pg8::gemm_phase<pg8::EpiStore, false>(lds, g, S, E, wave0); }
        }
        SEAM(P0 + 10);
        if (IN(P0 + 11)) { SITE(); pg8::Gemm g{WSP(bf16, WS_A), WSP(bf16, WS_WPLG), DM, DM}; pg8::StaticOrder S; S.init(M / 256, DM / 256, G, bx); pg8::EpiPlg E{ap->out, WSP(bf16, WS_PLEB)}; pg8::gemm_phase<pg8::EpiPlg, false>(lds, g, S, E, wave0); }
        SEAM(P0 + 11);
    }
#define FN_FIN(r, m) norm_fin_f32(r, g, H + (size_t)(m) * DM, lane)
    if (IN(DEPTH * PH_PER_LAYER)) { SITE(); float* H = ap->out; const float* g = ap->in[I_GFINAL]; ROW_STREAM(HN_SRC, FN_FIN);
    }
#undef IN
#undef SEAM
#undef SITE
#undef WSP
}

extern "C" void kernel_launch(void* const* d_in, const int* in_sizes, int n_in, void* d_out, int out_size, void* d_ws, size_t ws_size, hipStream_t stream) {
    static int grid = 0;
    if (grid == 0) {
        if (n_in != 26 || out_size != M * DM || ws_size < WS_END) { fprintf(stderr, "kernel_launch: expected 26 inputs, out %d, ws >= %zu; got n_in %d out %d ws %zu\n", M * DM, (size_t)WS_END, n_in, out_size, ws_size); grid = -1; return; }
        int dev = 0, cus = 0, per_cu = 0;
        if (hipGetDevice(&dev) != hipSuccess || hipDeviceGetAttribute(&cus, hipDeviceAttributeMultiprocessorCount, dev) != hipSuccess) { grid = -1; return; }
        if (hipFuncSetAttribute((const void*)fwd, hipFuncAttributeMaxDynamicSharedMemorySize, LDS_BYTES) != hipSuccess) { fprintf(stderr, "kernel_launch: hipFuncSetAttribute failed\n"); grid = -1; return; }
        if (hipOccupancyMaxActiveBlocksPerMultiprocessor(&per_cu, (const void*)fwd, NWAVES * 64, LDS_BYTES) != hipSuccess || per_cu < 1) { fprintf(stderr, "kernel_launch: occupancy query says %d\n", per_cu); }
        (void)hipGetLastError();
        grid = cus;
    }
    if (grid < 0) return;
    (void)hipMemsetAsync((char*)d_ws + WS_CTL, 0, CTL_ZERO_BYTES, stream);
    Args a{};
    for (int i = 0; i < 26; ++i) a.in[i] = (const float*)d_in[i];
    a.out = (float*)d_out; a.ws = (unsigned char*)d_ws; a.sub = 0xff; a.pad = 0;
#if MK_ONE_LAUNCH
    a.ph_lo = 0; a.ph_hi = N_PHASES;
    hipLaunchKernelGGL(fwd, dim3(grid), dim3(NWAVES * 64), LDS_BYTES, stream, a);
#else
    for (int p = 0; p < N_PHASES; ++p) { a.ph_lo = p; a.ph_hi = p + 1; a.sub = 0xff; hipLaunchKernelGGL(fwd, dim3(grid), dim3(NWAVES * 64), LDS_BYTES, stream, a);
#ifdef DUP_PH
        if (p < DEPTH * PH_PER_LAYER && (p % PH_PER_LAYER) == DUP_PH) { a.sub = DUP_SUB; hipLaunchKernelGGL(fwd, dim3(grid), dim3(NWAVES * 64), LDS_BYTES, stream, a); }
#endif
    }
#endif
    const hipError_t le = hipPeekAtLastError();
    if (le != hipSuccess) fprintf(stderr, "kernel_launch: launch failed: %s\n", hipGetErrorName(le));
}
```

```cpp
#include <hip/hip_runtime.h>
#include <cstdio>
#include <cstdint>

#ifndef MK_ONE_LAUNCH
#define MK_ONE_LAUNCH 1
#endif
#ifndef MLA_SDEPTH
#define MLA_SDEPTH 2
#endif

#define LAS __attribute__((address_space(3)))
#define GAS __attribute__((address_space(1)))
typedef unsigned short bf16;
typedef short bf16x8 __attribute__((ext_vector_type(8)));
typedef short s16x4 __attribute__((ext_vector_type(4)));
typedef float f32x2 __attribute__((ext_vector_type(2)));
typedef float f32x4 __attribute__((ext_vector_type(4)));
typedef float f32x16 __attribute__((ext_vector_type(16)));
typedef unsigned u32x2 __attribute__((ext_vector_type(2)));
typedef unsigned u32x4 __attribute__((ext_vector_type(4)));
typedef GAS unsigned gu32;

constexpr int DM = 2048, LP = 16384, LS = 2048, MP = 2 * LP, MS = 8 * LS, M = MP + MS;
constexpr int DEPTH = 4, IN_W = 3904, ZLD = 4096, DFF = 5632, PLE = 256;
constexpr int QW = 1536, KVW = 2048, VW = 1024;
constexpr float RMS_EPS = 1e-6f, LOG2E = 1.4426950408889634f;
constexpr int Z_CQ = 0, Z_CKV = 512, Z_NAQ = 768, Z_NAK = 1280, Z_NAV = 1792, Z_DQ = 2304, Z_DK = 2816, Z_DV = 3328, Z_KPE = 3840;
constexpr float SC_MLA = 0.07216878364870322f * LOG2E;
constexpr float SC_NA = 0.08838834764831845f * LOG2E;
constexpr float SC_DIFF = 0.125f * LOG2E;
constexpr int GU_TOK = 252;
constexpr int GU_NM = (M + GU_TOK - 1) / GU_TOK;

constexpr size_t MiB = 1u << 20;
constexpr size_t WS_CTL = 0, CTL_ZERO_BYTES = 1 * MiB;
constexpr size_t WS_ROPE = 1 * MiB;
constexpr size_t WS_QN = 5 * MiB;
constexpr size_t WS_KN = 6 * MiB + 512 * 1024;
constexpr size_t WS_WIN = 8 * MiB;
constexpr size_t WS_WQB = 24 * MiB;
constexpr size_t WS_WKVB = 26 * MiB;
constexpr size_t WS_WOUT = 27 * MiB;
constexpr size_t WS_WGU = 35 * MiB;
constexpr size_t WS_WDOWN = 79 * MiB;
constexpr size_t WS_WPLG = 101 * MiB;
constexpr size_t WS_WPLE = 109 * MiB;
constexpr size_t WS_PB = 112 * MiB;
constexpr size_t WS_A = 137 * MiB;
constexpr size_t WS_Z = 330 * MiB;
constexpr size_t WS_QM = 714 * MiB;
constexpr size_t WS_KM = 858 * MiB;
constexpr size_t WS_VM = 1002 * MiB;
constexpr size_t WS_DO = 1098 * MiB;
constexpr size_t WS_CQN = 1290 * MiB;
constexpr size_t WS_CKVN = 1338 * MiB;
constexpr size_t WS_SELF = 1362 * MiB;
constexpr size_t WS_END = 1364 * MiB;
constexpr size_t WS_ACT = 330 * MiB;
constexpr size_t WS_PLEB = 858 * MiB;
static_assert(WS_ACT + (size_t)M * DFF * 2 <= WS_KM && WS_PLEB + (size_t)M * DM * 2 <= WS_DO, "overlay map");
constexpr int CW_BAR = 4096;
constexpr int CW_DYN = 16384;

constexpr int RING_BYTES = 131072;
constexpr int MISC_OFF = RING_BYTES + 320;
constexpr int LDS_BYTES = 147456;
constexpr int NWAVES = 8;

#define RLX_AGENT __ATOMIC_RELAXED, __HIP_MEMORY_SCOPE_AGENT
#define LDS_WAIT() asm volatile("s_waitcnt lgkmcnt(0)" ::: "memory")
#define VM_WAIT() asm volatile("s_waitcnt vmcnt(0)" ::: "memory")
#define SBAR() __builtin_amdgcn_sched_barrier(0)

__device__ __forceinline__ unsigned f2bf(float f) { unsigned u = __builtin_bit_cast(unsigned, f); return (u + 0x7fffu + ((u >> 16) & 1u)) >> 16; }
__device__ __forceinline__ unsigned pk2(float lo, float hi) { return f2bf(lo) | (f2bf(hi) << 16); }
typedef __bf16 bf16x2_t __attribute__((ext_vector_type(2)));
typedef float f32x2_t __attribute__((ext_vector_type(2)));
__device__ __forceinline__ unsigned cvt_pk_bf16(float lo, float hi) { const f32x2_t v = {lo, hi}; return __builtin_bit_cast(unsigned, __builtin_convertvector(v, bf16x2_t)); }
__device__ __forceinline__ float bf_lo(unsigned w) { return __builtin_bit_cast(float, w << 16); }
__device__ __forceinline__ float bf_hi(unsigned w) { return __builtin_bit_cast(float, w & 0xffff0000u); }
__device__ __forceinline__ int lane_now() { int ln; asm volatile("v_mbcnt_lo_u32_b32 %0, -1, 0\n\tv_mbcnt_hi_u32_b32 %0, -1, %0" : "=&v"(ln)); return ln; }
__device__ __forceinline__ int opaque_tid(int wv) { const int ln = lane_now(); asm volatile("" : "+s"(wv)); return (wv << 6) | ln; }
template <int X> __device__ __forceinline__ float swz_xor(float v) { return __builtin_bit_cast(float, __builtin_amdgcn_ds_swizzle(__builtin_bit_cast(int, v), (X << 10) | 0x1f)); }
__device__ __forceinline__ float half_sum16(float v) { v += swz_xor<1>(v); v += swz_xor<2>(v); v += swz_xor<4>(v); v += swz_xor<8>(v); return v; }
__device__ __forceinline__ void xhalf_swap(float& a, float& b) { asm("s_nop 1\n\tv_permlane32_swap_b32 %0, %1" : "+v"(a), "+v"(b)); }
__device__ __forceinline__ float xhalf_sum(float v) { float a = v, b = v; xhalf_swap(a, b); return a + b; }
__device__ __forceinline__ float xhalf_max(float v) { float a = v, b = v; xhalf_swap(a, b); return fmaxf(a, b); }
__device__ __forceinline__ float wave_sum(float v) {
    v = half_sum16(v); v += swz_xor<16>(v);
    return xhalf_sum(v);
}
__device__ __forceinline__ float wave_max(float v) {
    v = fmaxf(v, swz_xor<1>(v)); v = fmaxf(v, swz_xor<2>(v)); v = fmaxf(v, swz_xor<4>(v)); v = fmaxf(v, swz_xor<8>(v)); v = fmaxf(v, swz_xor<16>(v));
    return xhalf_max(v);
}
__device__ __forceinline__ float lane_read(float v, int srclane) { return __builtin_bit_cast(float, __builtin_amdgcn_ds_bpermute(srclane << 2, __builtin_bit_cast(int, v))); }
__device__ __forceinline__ int seq_mask(int row) { return row < MP ? (LP - 1) : (LS - 1); }
__device__ __forceinline__ float gelu_tanh(float x) {
    const float t = x * __builtin_fmaf(x * x, 0.0356774081f, 0.7978845608f);
    const float e = __builtin_amdgcn_exp2f(-2.885390082f * t);
    return x * __builtin_amdgcn_rcpf(1.f + e);
}
__device__ __forceinline__ float sigmoidf_(float x) { return __builtin_amdgcn_rcpf(1.f + __builtin_amdgcn_exp2f(-LOG2E * x)); }

namespace pg8 {
constexpr int BM = 256, BK = 64, HALF = 128, HTB = HALF * BK * 2, NXCD = 8, WGM = 8;
__host__ __device__ __forceinline__ int lds_byte(int r, int c) { const int st = (r >> 4) * 2 + (c >> 5), rr = r & 15, cc = c & 31, ob = rr * 64 + cc * 2; return st * 1024 + (ob ^ (((ob >> 9) & 1) << 5)); }
__host__ __device__ __forceinline__ void stage_rc(int b, int& R, int& C) { const int st = b / 1024, sb = b % 1024, swz = sb ^ (((sb >> 9) & 1) << 5); R = (st >> 1) * 16 + swz / 64; C = (st & 1) * 32 + (swz % 64) / 2; }
__host__ __device__ __forceinline__ int perm32(int rho) { const int n = rho >> 4, i = rho & 15; return 8 * (i >> 2) + 4 * n + (i & 3); }

struct Unit { int pm, pn; };
struct Gemm { const bf16* A; const bf16* Bt; int lda, K; };

struct StaticOrder {
    int nM, nN, nwg, G, c;
    __device__ void init(int nM_, int nN_, int G_, int c_) { nM = nM_; nN = nN_; nwg = nM * nN; G = G_; c = c_; }
    __device__ bool next(int i, Unit& u) const {
        const long L = (long)i * G + c; if (L >= nwg) return false;
        int wgid = (int)L; { const int q = nwg / NXCD, r = nwg % NXCD, xcd = wgid % NXCD, off = wgid / NXCD; wgid = (xcd < r ? xcd * (q + 1) : r * (q + 1) + (xcd - r) * q) + off; }
        const int nig = WGM * nN, gid = wgid / nig, fm = gid * WGM, gsz = (nM - fm) < WGM ? (nM - fm) : WGM;
        u.pm = fm + ((wgid % nig) % gsz); u.pn = (wgid % nig) / gsz; return true;
    }
};

template <class Epi, bool PERMA>
__device__ __forceinline__ void gemm_phase(LAS unsigned char* lds, const Gemm g, const StaticOrder& S, const Epi& E, int wv) {
    const int tid = opaque_tid(wv), wid = __builtin_amdgcn_readfirstlane(tid >> 6), lane = tid & 63, wr = wid >> 2, wc = wid & 3, fr = lane & 15, fq = lane >> 4;
    const int K = g.K, lda = g.lda, nt = K / BK;
    unsigned voffA[2], voffB[2];
#pragma unroll
    for (int i = 0; i < 2; ++i) { int R, C; stage_rc(tid * 16 + i * 8192, R, C); const int Rb = (R & ~31) + perm32(R & 31);
        const int Ra = PERMA ? (126 * (R >> 6) + 8 * (R & 15) + ((R >> 4) & 3)) : R;
        voffA[i] = (unsigned)(Ra * lda + C) * 2u; voffB[i] = (unsigned)(Rb * K + C) * 2u; }
    const size_t kstep = (size_t)(BK * 2);
    const size_t hstepA = PERMA ? (size_t)4 * lda * 2 : (size_t)HALF * lda * 2;
    const size_t hstepB = (size_t)HALF * K * 2;
    const size_t tstepB = 2 * hstepB;
    const unsigned ldsw = (unsigned)wid * 1024u;
    const int aoff = lds_byte(wr * 64 + fr, fq * 8), boff = lds_byte(wc * 32 + fr, fq * 8);
#define PG8_ABASE(pm) (PERMA ? ((long)(pm) * GU_TOK - 1) * (long)lda * 2 : (long)(pm) * BM * (long)lda * 2)
#define PG8_SA(b, h) (((b) * 2 + (h)) * HTB)
#define PG8_SB(b, h) ((4 + (b) * 2 + (h)) * HTB)
#define PG8_STAGE(bufoff, gbase, voff) do { _Pragma("unroll") for (int _i = 0; _i < 2; ++_i) \
        __builtin_amdgcn_global_load_lds((const unsigned*)((const char*)(gbase) + (voff)[_i]), (LAS unsigned*)(lds + (bufoff) + ldsw + _i * 8192), 16, 0, 0); } while (0)
#define PG8_LDA(dst, b, h) do { _Pragma("unroll") for (int m = 0; m < 4; ++m) _Pragma("unroll") for (int k = 0; k < 2; ++k) dst[m][k] = *(const LAS bf16x8*)(lds + PG8_SA(b, h) + aoff + m * 2048 + k * 1024); } while (0)
#define PG8_LDB(dst, b, h) do { _Pragma("unroll") for (int n = 0; n < 2; ++n) _Pragma("unroll") for (int k = 0; k < 2; ++k) dst[n][k] = *(const LAS bf16x8*)(lds + PG8_SB(b, h) + boff + n * 2048 + k * 1024); } while (0)
#define PG8_MMA(ai, bj, At, Bt) do { __builtin_amdgcn_s_setprio(1); _Pragma("unroll") for (int m = 0; m < 4; ++m) _Pragma("unroll") for (int n = 0; n < 2; ++n) _Pragma("unroll") for (int k = 0; k < 2; ++k) \
        acc[ai][bj][m][n] = __builtin_amdgcn_mfma_f32_16x16x32_bf16(Bt[n][k], At[m][k], acc[ai][bj][m][n], 0, 0, 0); __builtin_amdgcn_s_setprio(0); } while (0)
#define PG8_WAIT_V(n) asm volatile("s_waitcnt vmcnt(" #n ")" ::: "memory")
#define PG8_WAIT_L(n) asm volatile("s_waitcnt lgkmcnt(" #n ")" ::: "memory")
#define PG8_BAR __builtin_amdgcn_s_barrier()
#define PG8_SCHED __builtin_amdgcn_sched_barrier(0)
    Unit cur, nxt; int ui = 0;
    if (!S.next(0, cur)) return;
    f32x4 acc[2][2][4][2];
#pragma unroll
    for (int a = 0; a < 2; ++a)
#pragma unroll
        for (int b = 0; b < 2; ++b)
#pragma unroll
            for (int m = 0; m < 4; ++m)
#pragma unroll
                for (int n = 0; n < 2; ++n) acc[a][b][m][n] = (f32x4){0.f, 0.f, 0.f, 0.f};
    bf16x8 At[4][2], B0[2][2], B1[2][2];
    const char* cA = (const char*)g.A + PG8_ABASE(cur.pm); const char* cB = (const char*)g.Bt + (size_t)cur.pn * tstepB;
    PG8_STAGE(PG8_SB(0, 0), cB, voffB); PG8_STAGE(PG8_SB(0, 1), cB + hstepB, voffB); PG8_STAGE(PG8_SA(0, 0), cA, voffA); PG8_STAGE(PG8_SA(0, 1), cA + hstepA, voffA);
    if (wr == 1) PG8_BAR;
    PG8_WAIT_V(2); PG8_BAR;
    PG8_STAGE(PG8_SB(1, 0), cB + kstep, voffB); PG8_STAGE(PG8_SA(1, 0), cA + kstep, voffA); PG8_STAGE(PG8_SB(1, 1), cB + hstepB + kstep, voffB);
    PG8_WAIT_V(6); PG8_BAR;
    for (;;) {
        const bool has_next = S.next(ui + 1, nxt);
        const char* nA = has_next ? (const char*)g.A + PG8_ABASE(nxt.pm) : cA; const char* nB = has_next ? (const char*)g.Bt + (size_t)nxt.pn * tstepB : cB;
#pragma unroll 1
        for (int t = 0; t < nt; t += 2) {
            const bool last = (t == nt - 2);
            const char* a1 = cA + (size_t)(t + 1) * kstep;
            const char* a2 = last ? nA : cA + (size_t)(t + 2) * kstep; const char* b2 = last ? nB : cB + (size_t)(t + 2) * kstep;
            const char* a3 = a2 + kstep; const char* b3 = b2 + kstep;
            PG8_LDB(B0, 0, 0); PG8_LDB(B1, 0, 1); PG8_SCHED; PG8_LDA(At, 0, 0); PG8_STAGE(PG8_SA(1, 1), a1 + hstepA, voffA);
            PG8_WAIT_V(8); PG8_WAIT_L(0); PG8_BAR; PG8_MMA(0, 0, At, B0); PG8_MMA(0, 1, At, B1); PG8_BAR; PG8_SCHED;
            PG8_LDA(At, 0, 1); PG8_STAGE(PG8_SB(0, 0), b2, voffB); PG8_STAGE(PG8_SB(0, 1), b2 + hstepB, voffB); PG8_STAGE(PG8_SA(0, 0), a2, voffA);
            PG8_WAIT_V(8); PG8_WAIT_L(0); PG8_BAR; PG8_MMA(1, 0, At, B0); PG8_MMA(1, 1, At, B1); PG8_BAR; PG8_SCHED;
            PG8_LDB(B0, 1, 0); PG8_LDB(B1, 1, 1); PG8_SCHED; PG8_LDA(At, 1, 0); PG8_STAGE(PG8_SA(0, 1), a2 + hstepA, voffA);
            PG8_WAIT_V(8); PG8_WAIT_L(0); PG8_BAR; PG8_MMA(0, 0, At, B0); PG8_MMA(0, 1, At, B1); PG8_BAR; PG8_SCHED;
            PG8_LDA(At, 1, 1); PG8_STAGE(PG8_SB(1, 0), b3, voffB); PG8_STAGE(PG8_SB(1, 1), b3 + hstepB, voffB); PG8_STAGE(PG8_SA(1, 0), a3, voffA);
            PG8_WAIT_V(8); PG8_WAIT_L(0); PG8_BAR; PG8_MMA(1, 0, At, B0); PG8_MMA(1, 1, At, B1); PG8_BAR; PG8_SCHED;
        }
        if (wr == 0) PG8_BAR;
        E(acc, cur, wr, wc, fr, fq);
        if (!has_next) break;
#pragma unroll
        for (int a = 0; a < 2; ++a)
#pragma unroll
            for (int b = 0; b < 2; ++b)
#pragma unroll
                for (int m = 0; m < 4; ++m)
#pragma unroll
                    for (int n = 0; n < 2; ++n) acc[a][b][m][n] = (f32x4){0.f, 0.f, 0.f, 0.f};
        cur = nxt; cA = nA; cB = nB; ++ui;
        if (wr == 1) PG8_BAR;
    }
    PG8_WAIT_V(0);
    PG8_BAR;
#undef PG8_ABASE
#undef PG8_SA
#undef PG8_SB
#undef PG8_STAGE
#undef PG8_LDA
#undef PG8_LDB
#undef PG8_MMA
#undef PG8_WAIT_V
#undef PG8_WAIT_L
#undef PG8_BAR
#undef PG8_SCHED
}

__device__ __forceinline__ u32x4 pack8(f32x4 v0, f32x4 v1) { u32x4 w; w.x = cvt_pk_bf16(v0[0], v0[1]); w.y = cvt_pk_bf16(v0[2], v0[3]); w.z = cvt_pk_bf16(v1[0], v1[1]); w.w = cvt_pk_bf16(v1[2], v1[3]); return w; }

struct EpiZ {
    bf16* Z;
    __device__ __forceinline__ void operator()(const f32x4 (&acc)[2][2][4][2], const Unit& u, int wr, int wc, int fr, int fq) const {
        const float sc = (u.pn == 3 || u.pn == 4) ? SC_NA : ((u.pn == 9 || u.pn == 10) ? SC_DIFF : 1.f);
        const int row0 = u.pm * BM + wr * 64 + fr, col0 = u.pn * BM + wc * 32 + 8 * fq;
#pragma unroll
        for (int ai = 0; ai < 2; ++ai)
#pragma unroll
            for (int m = 0; m < 4; ++m) { bf16* rowp = Z + (size_t)(row0 + ai * HALF + m * 16) * ZLD + col0;
#pragma unroll
                for (int bj = 0; bj < 2; ++bj) { u32x4 w = pack8(acc[ai][bj][m][0] * sc, acc[ai][bj][m][1] * sc);
                    *(u32x4*)(rowp + bj * HALF) = w; } }
    }
};
struct EpiStore {
    bf16* O; int ldc;
    __device__ __forceinline__ void operator()(const f32x4 (&acc)[2][2][4][2], const Unit& u, int wr, int wc, int fr, int fq) const {
        const int row0 = u.pm * BM + wr * 64 + fr, col0 = u.pn * BM + wc * 32 + 8 * fq;
#pragma unroll
        for (int ai = 0; ai < 2; ++ai)
#pragma unroll
            for (int m = 0; m < 4; ++m) { bf16* rowp = O + (size_t)(row0 + ai * HALF + m * 16) * ldc + col0;
#pragma unroll
                for (int bj = 0; bj < 2; ++bj) *(u32x4*)(rowp + bj * HALF) = pack8(acc[ai][bj][m][0], acc[ai][bj][m][1]); }
    }
};
struct EpiQ {
    bf16* Q; const float* rope;
    __device__ __forceinline__ void operator()(const f32x4 (&acc)[2][2][4][2], const Unit& u, int wr, int wc, int fr, int fq) const {
        const int row0 = u.pm * BM + wr * 64 + fr;
#pragma unroll
        for (int bj = 0; bj < 2; ++bj) {
            const int c8 = u.pn * BM + bj * HALF + wc * 32 + 8 * fq, cin = c8 % 192; const bool isrope = cin >= 128; const int j0 = (cin - 128) >> 1;
#pragma unroll
            for (int ai = 0; ai < 2; ++ai)
#pragma unroll
                for (int m = 0; m < 4; ++m) { const int row = row0 + ai * HALF + m * 16;
                    f32x4 v0 = acc[ai][bj][m][0] * SC_MLA, v1 = acc[ai][bj][m][1] * SC_MLA;
                    if (isrope) { const int pos = row & seq_mask(row); const f32x4* t = (const f32x4*)(rope + ((size_t)pos * 32 + j0) * 2); const f32x4 c0 = t[0], c1 = t[1];
                        f32x4 o0, o1;
                        o0[0] = v0[0] * c0[0] - v0[1] * c0[1]; o0[1] = v0[0] * c0[1] + v0[1] * c0[0]; o0[2] = v0[2] * c0[2] - v0[3] * c0[3]; o0[3] = v0[2] * c0[3] + v0[3] * c0[2];
                        o1[0] = v1[0] * c1[0] - v1[1] * c1[1]; o1[1] = v1[0] * c1[1] + v1[1] * c1[0]; o1[2] = v1[2] * c1[2] - v1[3] * c1[3]; o1[3] = v1[2] * c1[3] + v1[3] * c1[2];
                        v0 = o0; v1 = o1;
                    }
                    *(u32x4*)(Q + (size_t)row * QW + c8) = pack8(v0, v1); }
        }
    }
};
struct EpiKV {
    bf16* KM; bf16* VM;
    __device__ __forceinline__ void operator()(const f32x4 (&acc)[2][2][4][2], const Unit& u, int wr, int wc, int fr, int fq) const {
        const int row0 = u.pm * BM + wr * 64 + fr, cw = wc * 32 + 8 * fq;
#pragma unroll
        for (int ai = 0; ai < 2; ++ai)
#pragma unroll
            for (int m = 0; m < 4; ++m) { const size_t row = (size_t)(row0 + ai * HALF + m * 16);
                *(u32x4*)(KM + row * QW + u.pn * 192 + cw) = pack8(acc[ai][0][m][0], acc[ai][0][m][1]);
                *(u32x4*)(VM + row * VW + u.pn * 128 + cw) = pack8(acc[ai][1][m][0], acc[ai][1][m][1]); }
    }
};
struct EpiRes {
    float* H; const float* xp; const float* xs;
    __device__ __forceinline__ void operator()(const f32x4 (&acc)[2][2][4][2], const Unit& u, int wr, int wc, int fr, int fq) const {
        const int row0 = u.pm * BM + wr * 64 + fr, col0 = u.pn * BM + wc * 32 + 8 * fq;
        const float* S = xp ? (u.pm * BM < MP ? xp : xs - (size_t)MP * DM) : (const float*)H;
#pragma unroll
        for (int ai = 0; ai < 2; ++ai)
#pragma unroll
            for (int m = 0; m < 4; ++m) { const size_t off = (size_t)(row0 + ai * HALF + m * 16) * DM + col0;
#pragma unroll
                for (int bj = 0; bj < 2; ++bj) { const f32x4* q = (const f32x4*)(S + off + bj * HALF); f32x4* p = (f32x4*)(H + off + bj * HALF); const f32x4 h0 = q[0], h1 = q[1]; p[0] = h0 + acc[ai][bj][m][0]; p[1] = h1 + acc[ai][bj][m][1]; } }
    }
};
struct EpiPlg {
    float* H; const bf16* PL;
    __device__ __forceinline__ void operator()(const f32x4 (&acc)[2][2][4][2], const Unit& u, int wr, int wc, int fr, int fq) const {
        const int row0 = u.pm * BM + wr * 64 + fr, col0 = u.pn * BM + wc * 32 + 8 * fq;
#pragma unroll
        for (int ai = 0; ai < 2; ++ai)
#pragma unroll
            for (int m = 0; m < 4; ++m) { const size_t off = (size_t)(row0 + ai * HALF + m * 16) * DM + col0;
#pragma unroll
                for (int bj = 0; bj < 2; ++bj) { f32x4* p = (f32x4*)(H + off + bj * HALF); const u32x4 e = *(const u32x4*)(PL + off + bj * HALF);
                    const f32x4 a0 = acc[ai][bj][m][0], a1 = acc[ai][bj][m][1]; f32x4 h0 = p[0], h1 = p[1];
                    h0[0] += bf_lo(e.x) * sigmoidf_(a0[0]); h0[1] += bf_hi(e.x) * sigmoidf_(a0[1]); h0[2] += bf_lo(e.y) * sigmoidf_(a0[2]); h0[3] += bf_hi(e.y) * sigmoidf_(a0[3]);
                    h1[0] += bf_lo(e.z) * sigmoidf_(a1[0]); h1[1] += bf_hi(e.z) * sigmoidf_(a1[1]); h1[2] += bf_lo(e.w) * sigmoidf_(a1[2]); h1[3] += bf_hi(e.w) * sigmoidf_(a1[3]);
                    p[0] = h0; p[1] = h1; } }
    }
};
struct EpiGU {
    bf16* ACT; const float* cw; const float* cb;
    __device__ __forceinline__ void operator()(const f32x4 (&acc)[2][2][4][2], const Unit& u, int wr, int wc, int fr, int fq) const {
        const int lane = fr + 16 * fq;
        const int t0 = u.pm * GU_TOK - 1 + 126 * wr + 8 * fr;
        const int f0 = u.pn * 128 + wc * 32 + 8 * fq;
        bool first[8], last[8];
#pragma unroll
        for (int k = 0; k < 8; ++k) { const int t = t0 + k, mk = seq_mask(t); first[k] = (t & mk) == 0; last[k] = ((t + 1) & mk) == 0; }
        unsigned outw[8][4];
#pragma unroll
        for (int n = 0; n < 2; ++n) {
            const f32x4 w0 = *(const f32x4*)(cw + f0 + 4 * n), w1 = *(const f32x4*)(cw + DFF + f0 + 4 * n), w2 = *(const f32x4*)(cw + 2 * DFF + f0 + 4 * n), bb = *(const f32x4*)(cb + f0 + 4 * n);
            float res[8][4];
#pragma unroll
            for (int e = 0; e < 4; ++e) {
                float gv[10];
#pragma unroll
                for (int k = 0; k < 8; ++k) gv[k + 1] = acc[k >> 2][0][k & 3][n][e];
                gv[0] = lane_read(gv[8], (lane + 63) & 63); gv[9] = lane_read(gv[1], (lane + 1) & 63);
#pragma unroll
                for (int k = 0; k < 8; ++k) {
                    float c = __builtin_fmaf(w1[e], gv[k + 1], bb[e]);
                    c += first[k] ? 0.f : w0[e] * gv[k];
                    c += last[k] ? 0.f : w2[e] * gv[k + 2];
                    res[k][e] = gelu_tanh(c) * acc[k >> 2][1][k & 3][n][e];
                }
            }
#pragma unroll
            for (int k = 0; k < 8; ++k) { outw[k][2 * n] = cvt_pk_bf16(res[k][0], res[k][1]); outw[k][2 * n + 1] = cvt_pk_bf16(res[k][2], res[k][3]); }
        }
#pragma unroll
        for (int k = 0; k < 8; ++k) { const int t = t0 + k;
            const bool ok = !(fr == 0 && k == 0) && !(fr == 15 && k == 7) && t < M;
            if (ok) { u32x4 w; w.x = outw[k][0]; w.y = outw[k][1]; w.z = outw[k][2]; w.w = outw[k][3]; *(u32x4*)(ACT + (size_t)t * DFF + f0) = w; } }
    }
};
}

namespace att {
constexpr int NW = 8, QBLK = 32, KVBLK = 64, DV = 128;
constexpr int SHM_V = KVBLK * DV * 2;
constexpr int OFF_V = 0, OFF_K = 3 * SHM_V, OFF_WS = 122880, OFF_TAB = 124928, ATT_LDS = 126976;
constexpr float THR2 = 11.5f;
constexpr float NEG_BIG = -1e30f;
__device__ __forceinline__ int crow(int r, int hi) { return (r & 3) + 8 * (r >> 2) + 4 * hi; }
__device__ __forceinline__ int v_st(int k, int c) { const int kk = (k & ~0xC) | ((k & 4) << 1) | ((k & 8) >> 1); return ((kk >> 3) * 4 + (c >> 5)) * 512 + ((kk & 7) * 32 + (c & 31)) * 2; }
__device__ __forceinline__ int v_rd_base(int lane) { return ((lane & 3) << 3) | (((lane >> 2) & 3) << 6) | (((lane >> 4) & 1) << 5) | (((lane >> 5) & 1) << 8); }
constexpr int v_rd_off(int d0, int ks, int half) { return d0 * 512 + ks * 4096 + half * 2048; }
template <int OFF> __device__ __forceinline__ s16x4 tr_read(int vb) {
    s16x4 r; asm volatile("ds_read_b64_tr_b16 %0, %1 offset:%2" : "=&v"(r) : "v"(vb), "i"(OFF) : "memory"); return r;
}
template <int D0> __device__ __forceinline__ void pv_one(f32x16& od, int vb, bf16x8 pa0, bf16x8 pa1, bf16x8 pa2, bf16x8 pa3) {
    s16x4 l0 = tr_read<v_rd_off(D0, 0, 0)>(vb), h0 = tr_read<v_rd_off(D0, 0, 1)>(vb), l1 = tr_read<v_rd_off(D0, 1, 0)>(vb), h1 = tr_read<v_rd_off(D0, 1, 1)>(vb);
    s16x4 l2 = tr_read<v_rd_off(D0, 2, 0)>(vb), h2 = tr_read<v_rd_off(D0, 2, 1)>(vb), l3 = tr_read<v_rd_off(D0, 3, 0)>(vb), h3 = tr_read<v_rd_off(D0, 3, 1)>(vb);
    asm volatile("s_waitcnt lgkmcnt(0)" : "+v"(l0), "+v"(h0), "+v"(l1), "+v"(h1), "+v"(l2), "+v"(h2), "+v"(l3), "+v"(h3) :: "memory");
#define PK(L, H) (bf16x8){L[0], L[1], L[2], L[3], H[0], H[1], H[2], H[3]}
    od = __builtin_amdgcn_mfma_f32_32x32x16_bf16(pa0, PK(l0, h0), od, 0, 0, 0);
    od = __builtin_amdgcn_mfma_f32_32x32x16_bf16(pa1, PK(l1, h1), od, 0, 0, 0);
    od = __builtin_amdgcn_mfma_f32_32x32x16_bf16(pa2, PK(l2, h2), od, 0, 0, 0);
    od = __builtin_amdgcn_mfma_f32_32x32x16_bf16(pa3, PK(l3, h3), od, 0, 0, 0);
#undef PK
}
__device__ __forceinline__ void pv_d0(f32x16* o, int vb, bf16x8 pa0, bf16x8 pa1, bf16x8 pa2, bf16x8 pa3) {
    pv_one<0>(o[0], vb, pa0, pa1, pa2, pa3); pv_one<1>(o[1], vb, pa0, pa1, pa2, pa3); pv_one<2>(o[2], vb, pa0, pa1, pa2, pa3); pv_one<3>(o[3], vb, pa0, pa1, pa2, pa3);
}
template <int D0> __device__ __forceinline__ void v_frags(int vb, s16x4 (&f)[8]) {
    f[0] = tr_read<v_rd_off(D0, 0, 0)>(vb); f[1] = tr_read<v_rd_off(D0, 0, 1)>(vb); f[2] = tr_read<v_rd_off(D0, 1, 0)>(vb); f[3] = tr_read<v_rd_off(D0, 1, 1)>(vb);
    f[4] = tr_read<v_rd_off(D0, 2, 0)>(vb); f[5] = tr_read<v_rd_off(D0, 2, 1)>(vb); f[6] = tr_read<v_rd_off(D0, 3, 0)>(vb); f[7] = tr_read<v_rd_off(D0, 3, 1)>(vb);
}
__device__ __forceinline__ void v_mma(f32x16& od, s16x4 (&f)[8], bf16x8 pa0, bf16x8 pa1, bf16x8 pa2, bf16x8 pa3) {
    asm volatile("s_waitcnt lgkmcnt(0)" : "+v"(f[0]), "+v"(f[1]), "+v"(f[2]), "+v"(f[3]), "+v"(f[4]), "+v"(f[5]), "+v"(f[6]), "+v"(f[7]) :: "memory");
#define PK(L, H) (bf16x8){L[0], L[1], L[2], L[3], H[0], H[1], H[2], H[3]}
    od = __builtin_amdgcn_mfma_f32_32x32x16_bf16(pa0, PK(f[0], f[1]), od, 0, 0, 0);
    od = __builtin_amdgcn_mfma_f32_32x32x16_bf16(pa1, PK(f[2], f[3]), od, 0, 0, 0);
    od = __builtin_amdgcn_mfma_f32_32x32x16_bf16(pa2, PK(f[4], f[5]), od, 0, 0, 0);
    od = __builtin_amdgcn_mfma_f32_32x32x16_bf16(pa3, PK(f[6], f[7]), od, 0, 0, 0);
#undef PK
}
struct Hook {
    float dl, nslope, sref;
    int tq0;
    int rs, qgr, kr0, relbase, lo;
    const LAS float* tab;
};
template <int MODE>
__device__ __forceinline__ void score_hook(f32x16& p0, f32x16& p1, int j, const Hook& H) {
    if constexpr (MODE == 1) {
        const float t0 = H.dl - (float)(64 * j);
        const int tq = H.tq0 - 64 * j;
        if (tq >= 63 || tq <= -31) {
            const float sn = tq > 0 ? H.nslope : -H.nslope;
#pragma unroll
            for (int r = 0; r < 16; ++r) { const float cr = (float)((r & 3) + 8 * (r >> 2));
                p0[r] = __builtin_fmaf(t0 - cr, sn, p0[r]);
                p1[r] = __builtin_fmaf(t0 - 32.f - cr, sn, p1[r]); }
        } else {
#pragma unroll
            for (int r = 0; r < 16; ++r) { const float cr = (float)((r & 3) + 8 * (r >> 2));
                p0[r] = __builtin_fmaf(__builtin_fabsf(t0 - cr), H.nslope, p0[r]);
                p1[r] = __builtin_fmaf(__builtin_fabsf(t0 - 32.f - cr), H.nslope, p1[r]); } }
    } else if constexpr (MODE == 2) {
        const int kr = H.kr0 + j; const bool rowok = __builtin_amdgcn_readfirstlane((int)((unsigned)(kr - H.rs) < 8u)) != 0;
        if (!rowok) {
#pragma unroll
            for (int r = 0; r < 16; ++r) { p0[r] = NEG_BIG; p1[r] = NEG_BIG; }
            return; }
        int trow = kr - H.qgr + 7; trow = trow < 0 ? 0 : (trow > 14 ? 14 : trow);
        int rb = H.relbase; asm volatile("" : "+v"(rb));
        const LAS float* tr = H.tab + (trow * 16 + H.lo) * 18;
#pragma unroll
        for (int r = 0; r < 16; ++r) { const int cr = (r & 3) + 8 * (r >> 2);
            { int e = rb + cr; e = e < 0 ? 0 : (e > 17 ? 17 : e); p0[r] += tr[e]; }
            { int e = rb + cr + 32; e = e < 0 ? 0 : (e > 17 ? 17 : e); p1[r] += tr[e]; } }
    }
}
template <int MODE>
__device__ __forceinline__ void partialSM(f32x16& p0, f32x16& p1, float& m_reg, float& mn, float& alpha, int j, const Hook& H) {
    score_hook<MODE>(p0, p1, j, H);
    float pmax = p0[0];
#pragma unroll
    for (int r = 1; r < 16; ++r) pmax = fmaxf(pmax, p0[r]);
#pragma unroll
    for (int r = 0; r < 16; ++r) pmax = fmaxf(pmax, p1[r]);
    pmax = xhalf_max(pmax);
    if (__builtin_expect(__all(pmax - m_reg <= THR2), 1)) { mn = m_reg; alpha = 1.f; }
    else { mn = fmaxf(m_reg, pmax); alpha = __builtin_amdgcn_exp2f(m_reg - mn); m_reg = mn; }
#pragma unroll
    for (int r = 0; r < 16; ++r) p0[r] = p0[r] - mn;
#pragma unroll
    for (int r = 0; r < 16; ++r) p1[r] = p1[r] - mn;
}
__device__ __forceinline__ void finishSM(f32x16& p0, f32x16& p1, float alpha, float& l_reg, bf16x8& pa0, bf16x8& pa1, bf16x8& pa2, bf16x8& pa3) {
#pragma unroll
    for (int r = 0; r < 16; ++r) p0[r] = __builtin_amdgcn_exp2f(p0[r]);
#pragma unroll
    for (int r = 0; r < 16; ++r) p1[r] = __builtin_amdgcn_exp2f(p1[r]);
    float ps = 0;
#pragma unroll
    for (int r = 0; r < 16; ++r) ps += p0[r];
#pragma unroll
    for (int r = 0; r < 16; ++r) ps += p1[r];
    ps = xhalf_sum(ps);
    l_reg = l_reg * alpha + ps;
#define PK4(P, BASE, OUT) do { unsigned a0 = cvt_pk_bf16(P[BASE + 0], P[BASE + 1]), a1 = cvt_pk_bf16(P[BASE + 2], P[BASE + 3]);   \
    unsigned b0 = cvt_pk_bf16(P[BASE + 4], P[BASE + 5]), b1 = cvt_pk_bf16(P[BASE + 6], P[BASE + 7]);                              \
    auto r0 = __builtin_amdgcn_permlane32_swap(a0, b0, false, false); auto r1 = __builtin_amdgcn_permlane32_swap(a1, b1, false, false); \
    u32x4 w = {r0[0], r1[0], r0[1], r1[1]}; OUT = *reinterpret_cast<bf16x8*>(&w); } while (0)
    PK4(p0, 0, pa0); PK4(p0, 8, pa1); PK4(p1, 0, pa2); PK4(p1, 8, pa3);
#undef PK4
}
template <int DQK> __device__ __forceinline__ int kswz(int row) { return DQK == 128 ? (row & 15) : ((row >> 1) & 7); }
template <int DQK> constexpr int KNB = DQK == 128 ? 8 : 4;
template <int DQK> __device__ __forceinline__ void k_offsets(int (&kofs)[KNB<DQK>], int r32, int hi) {
#pragma unroll
    for (int i = 0; i < KNB<DQK>; ++i) kofs[i] = r32 * (DQK * 2) + ((i * 32 + hi * 16) ^ (kswz<DQK>(r32) << 4));
}
template <int DQK> __device__ __forceinline__ void k_first(bf16x8& k0, bf16x8& k1, const char* Ks, const int (&kofs)[KNB<DQK>]) {
    k0 = *reinterpret_cast<const bf16x8*>(Ks + kofs[0]); k1 = *reinterpret_cast<const bf16x8*>(Ks + kofs[0] + 32 * (DQK * 2)); }
template <int DQK, bool CINIT>
__device__ __forceinline__ void qkt(f32x16& p0, f32x16& p1, const char* Ks, const int (&kofs)[KNB<DQK>], const bf16x8* qr, bf16x8 k0, bf16x8 k1, const f32x16& nm) {
    if constexpr (CINIT) { p0 = __builtin_amdgcn_mfma_f32_32x32x16_bf16(k0, qr[0], nm, 0, 0, 0); p1 = __builtin_amdgcn_mfma_f32_32x32x16_bf16(k1, qr[0], nm, 0, 0, 0); }
    else { p0 = __builtin_amdgcn_mfma_f32_32x32x16_bf16(k0, qr[0], f32x16{}, 0, 0, 0); p1 = __builtin_amdgcn_mfma_f32_32x32x16_bf16(k1, qr[0], f32x16{}, 0, 0, 0); }
    SBAR();
#pragma unroll
    for (int d0 = 1; d0 < DQK / 16; ++d0) {
        const char* kp = DQK == 128 ? Ks + (kofs[0] ^ (d0 << 5)) : Ks + kofs[d0 % KNB<DQK>] + (d0 / KNB<DQK>) * (KNB<DQK> * 32);
        bf16x8 b0 = *reinterpret_cast<const bf16x8*>(kp);
        bf16x8 b1 = *reinterpret_cast<const bf16x8*>(kp + 32 * (DQK * 2));
        p0 = __builtin_amdgcn_mfma_f32_32x32x16_bf16(b0, qr[d0], p0, 0, 0, 0);
        p1 = __builtin_amdgcn_mfma_f32_32x32x16_bf16(b1, qr[d0], p1, 0, 0, 0); }
}
template <int MODE>
__device__ __forceinline__ void partialSM_relA(f32x16& p0, f32x16& p1, float& delta, bool& shifted, float& alpha, bool& rare, int j, const Hook& H) {
    score_hook<MODE>(p0, p1, j, H);
    float pmax = p0[0];
#pragma unroll
    for (int r = 1; r < 16; ++r) pmax = fmaxf(pmax, p0[r]);
#pragma unroll
    for (int r = 0; r < 16; ++r) pmax = fmaxf(pmax, p1[r]);
    pmax = xhalf_max(pmax) - delta;
    rare = !__all(pmax <= THR2);
    const float d = rare ? fmaxf(pmax, 0.f) : 0.f;
    alpha = __builtin_amdgcn_exp2f(-d); delta += d; shifted = shifted || rare;
}
__device__ __forceinline__ void partialSM_relB(f32x16& p0, f32x16& p1, float delta, bool shifted, float alpha, bool rare, f32x16* o, float* al_l) {
    if (__builtin_expect(shifted, 0)) {
        if (rare) {
            const int ln = lane_now(), hi = ln >> 5; if (hi == 0) al_l[ln] = alpha; asm volatile("s_waitcnt lgkmcnt(0)" ::: "memory");
#pragma unroll
            for (int dd = 0; dd < 4; ++dd)
#pragma unroll
                for (int r = 0; r < 16; ++r) o[dd][r] *= al_l[crow(r, hi)];
        }
#pragma unroll
        for (int r = 0; r < 16; ++r) { p0[r] -= delta; p1[r] -= delta; }
    }
}
__device__ __forceinline__ void store_o(float* p, float v) { *p = v; }
__device__ __forceinline__ void store_o(bf16* p, float v) { *p = (bf16)f2bf(v); }

__device__ __forceinline__ void glds16(const void* gsrc, unsigned lds_dst) { unsigned keep;
    asm volatile("s_mov_b32 %0, m0\n\ts_mov_b32 m0, %2\n\ts_nop 0\n\tglobal_load_lds_dwordx4 %1, off\n\ts_mov_b32 m0, %0" : "=&s"(keep) : "v"(gsrc), "s"(lds_dst) : "memory"); }
#define ATT_WAIT_BAR(N) asm volatile("s_waitcnt vmcnt(%0) lgkmcnt(0)\n\ts_barrier" :: "n"(N) : "memory")
#define ATT_BAR() asm volatile("s_waitcnt lgkmcnt(0)\n\ts_barrier" ::: "memory")

template <int DQK, int MODE, int LDQ, int LDK, int LDV, int LDO, typename TO>
__device__ __forceinline__ void attn_body(const bf16* __restrict__ Qb, const bf16* __restrict__ Kh, const bf16* __restrict__ Vh, TO* __restrict__ Ob, int NT, const Hook& H, char* lds, int wv) {
    constexpr int SHM_K = KVBLK * DQK * 2, KC = DQK / 64, UPR = DQK / 8, NLD = KC + 2;
    const int tid = opaque_tid(wv), wid = __builtin_amdgcn_readfirstlane(tid >> 6), lane = tid & 63, r32 = lane & 31, hi = lane >> 5;
    char* V_lds = lds + OFF_V; char* K_lds = lds + OFF_K;
    float* ws = (float*)(lds + OFF_WS) + wid * 64; float* li_l = ws; float* al_l = ws + 32;
    float m_reg = MODE == 1 ? H.sref : NEG_BIG, l_reg = 0; f32x16 o[4] = {}; bf16x8 qr[DQK / 16];
    const bf16* Qw = Qb + (long)(wid * QBLK + r32) * LDQ + hi * 8;
#pragma unroll
    for (int d0 = 0; d0 < DQK / 16; ++d0) qr[d0] = *reinterpret_cast<const bf16x8*>(Qw + d0 * 16);
    unsigned koff[KC], voff[2];
#pragma unroll
    for (int c = 0; c < KC; ++c) { const int U = 64 * (8 * c + wid) + lane, row = U / UPR, cu = U - row * UPR, q8 = cu ^ kswz<DQK>(row); koff[c] = (unsigned)(row * LDK + q8 * 8) * 2u; }
#pragma unroll
    for (int c = 0; c < 2; ++c) { const int U = 64 * (8 * c + wid) + lane, sub = U >> 5, kk = (sub >> 2) * 8 + ((U >> 2) & 7), k = (kk & ~0xC) | ((kk & 4) << 1) | ((kk & 8) >> 1), col = (sub & 3) * 32 + (U & 3) * 8;
        voff[c] = (unsigned)(k * LDV + col) * 2u; }
    const unsigned ldsK = (unsigned)(uintptr_t)K_lds + (unsigned)wid * 1024u, ldsV = (unsigned)(uintptr_t)V_lds + (unsigned)wid * 1024u;
    const int vb0 = (int)(uintptr_t)V_lds + v_rd_base(lane);
    int kofs[KNB<DQK>]; k_offsets<DQK>(kofs, r32, hi);
#define DMA(t, b) do { const char* _kg = (const char*)Kh + (size_t)(t) * (KVBLK * LDK * 2); const char* _vg = (const char*)Vh + (size_t)(t) * (KVBLK * LDV * 2); \
    _Pragma("unroll") for (int _c = 0; _c < KC; ++_c) glds16(_kg + koff[_c], (unsigned)__builtin_amdgcn_readfirstlane(ldsK + (b) * SHM_K + _c * 8192)); \
    _Pragma("unroll") for (int _c = 0; _c < 2; ++_c) glds16(_vg + voff[_c], (unsigned)__builtin_amdgcn_readfirstlane(ldsV + (b) * SHM_V + _c * 8192)); } while (0)
#define RESC_IF(c, a) do { if (c) { const int _ln = lane_now(), _hi = _ln >> 5; if (_hi == 0) al_l[_ln] = (a); asm volatile("s_waitcnt lgkmcnt(0)" ::: "memory"); \
    _Pragma("unroll") for (int d = 0; d < 4; ++d) _Pragma("unroll") for (int r = 0; r < 16; ++r) o[d][r] *= al_l[crow(r, _hi)]; } } while (0)
    f32x16 pA0, pA1, pB0, pB1; float mnA, mnB, alA, alB; bf16x8 pa0, pa1, pa2, pa3;
    DMA(0, 0); DMA(1, 1);
    ATT_WAIT_BAR(NLD);
    const int rs_u = MODE == 2 ? __builtin_amdgcn_readfirstlane(H.rs - H.kr0) : 0;
#define VOK(t) (MODE != 2 || (unsigned)((t) - rs_u) < 8u)
    f32x16 nm = {}; bf16x8 kf0, kf1;
    k_first<DQK>(kf0, kf1, K_lds, kofs);
    if (VOK(0)) { qkt<DQK, false>(pA0, pA1, K_lds, kofs, qr, kf0, kf1, nm); partialSM<MODE>(pA0, pA1, m_reg, mnA, alA, 0, H); }
    float delta = 0.f; bool shifted = false;
    if constexpr (MODE != 2) {
#pragma unroll
        for (int r = 0; r < 16; ++r) nm[r] = -m_reg; }
#define QKT(P0, P1, KS) qkt<DQK, MODE != 2>(P0, P1, KS, kofs, qr, kf0, kf1, nm)
#define PVPSM(VB, P0, P1, MN, AL, J) do { if constexpr (MODE != 2) { bool _rare; const int _vb = (VB); s16x4 _f3[8]; \
            pv_one<0>(o[0], _vb, pa0, pa1, pa2, pa3); pv_one<1>(o[1], _vb, pa0, pa1, pa2, pa3); pv_one<2>(o[2], _vb, pa0, pa1, pa2, pa3); \
            v_frags<3>(_vb, _f3); partialSM_relA<MODE>(P0, P1, delta, shifted, AL, _rare, J, H); \
            v_mma(o[3], _f3, pa0, pa1, pa2, pa3); \
            partialSM_relB(P0, P1, delta, shifted, AL, _rare, o, al_l); } \
        else { if (VOK((J) - 1)) pv_d0(o, (VB), pa0, pa1, pa2, pa3); if (VOK(J)) { partialSM<MODE>(P0, P1, m_reg, MN, AL, J, H); RESC_IF(__any((AL) < 1.f), AL); } } } while (0)
    ATT_WAIT_BAR(0);
    k_first<DQK>(kf0, kf1, K_lds + SHM_K, kofs);
    if (2 < NT) DMA(2, 2);
    int bp = 0, bc = 1, bn = 2;
    for (int j = 1; j + 1 < NT; j += 2) {
        if (VOK(j)) QKT(pB0, pB1, K_lds + bc * SHM_K);
        if (VOK(j - 1)) finishSM(pA0, pA1, alA, l_reg, pa0, pa1, pa2, pa3);
        PVPSM(vb0 + bp * SHM_V, pB0, pB1, mnB, alB, j);
        ATT_WAIT_BAR(0);
        k_first<DQK>(kf0, kf1, K_lds + bn * SHM_K, kofs);
        DMA(j + 2, bp);
        { const int t = bp; bp = bc; bc = bn; bn = t; }
        if (VOK(j + 1)) QKT(pA0, pA1, K_lds + bc * SHM_K);
        if (VOK(j)) finishSM(pB0, pB1, alB, l_reg, pa0, pa1, pa2, pa3);
        PVPSM(vb0 + bp * SHM_V, pA0, pA1, mnA, alA, j + 1);
        ATT_WAIT_BAR(0);
        k_first<DQK>(kf0, kf1, K_lds + bn * SHM_K, kofs);
        if (j + 3 < NT) DMA(j + 3, bp);
        { const int t = bp; bp = bc; bc = bn; bn = t; }
    }
    SBAR(); if (VOK(NT - 1)) QKT(pB0, pB1, K_lds + bc * SHM_K);
    if (VOK(NT - 2)) finishSM(pA0, pA1, alA, l_reg, pa0, pa1, pa2, pa3); SBAR();
    PVPSM(vb0 + bp * SHM_V, pB0, pB1, mnB, alB, NT - 1);
    if (VOK(NT - 1)) { finishSM(pB0, pB1, alB, l_reg, pa0, pa1, pa2, pa3); SBAR();
        pv_d0(o, vb0 + bc * SHM_V, pa0, pa1, pa2, pa3); }
    const int ln2 = lane_now(), r32e = ln2 & 31, hie = ln2 >> 5;
    if (hie == 0) li_l[r32e] = l_reg; asm volatile("s_waitcnt lgkmcnt(0)" ::: "memory");
    float rli[16];
#pragma unroll
    for (int r = 0; r < 16; ++r) rli[r] = __builtin_amdgcn_rcpf(li_l[crow(r, hie)]);
    TO* Ow = Ob + (long)(wid * QBLK) * LDO;
    if constexpr (sizeof(TO) == 2) {
        constexpr int RS = 272;
        ATT_BAR();
        char* st = lds + wid * (QBLK * RS);
#pragma unroll
        for (int r = 0; r < 16; ++r) { const int orow = crow(r, hie);
#pragma unroll
            for (int d0 = 0; d0 < 4; ++d0) *(bf16*)(st + orow * RS + (d0 * 32 + r32e) * 2) = (bf16)f2bf(o[d0][r] * rli[r]); }
        asm volatile("s_waitcnt lgkmcnt(0)" ::: "memory");
#pragma unroll
        for (int k = 0; k < 8; ++k) { const int row = (ln2 >> 4) + 4 * k, c8 = ln2 & 15;
            const u32x4 w = *(const u32x4*)(st + row * RS + c8 * 16);
            *(u32x4*)((bf16*)Ow + (long)row * LDO + c8 * 8) = w; }
    } else {
#pragma unroll
        for (int r = 0; r < 16; ++r) { const int orow = crow(r, hie);
#pragma unroll
            for (int d0 = 0; d0 < 4; ++d0) store_o(Ow + (long)orow * LDO + d0 * 32 + r32e, o[d0][r] * rli[r]); }
    }
#undef DMA
#undef RESC_IF
#undef QKT
#undef PVPSM
#undef VOK
}
}

#define XB_TMO      128
#define XB_XCNT(j)  (256  + 64 * (j))
#define XB_XSUB(j)  (1280 + 64 * (j))
#define XB_XGEN(j)  (2304 + 64 * (j))
#define XB_TOP      3328
#define XB_TOPGEN   3392
#define XCD_BAR_WORDS 3456
#define XB_SPIN_CAP (1u << 22)
__device__ __forceinline__ unsigned xb_ld(unsigned* p)              { return __hip_atomic_load(p, __ATOMIC_RELAXED, __HIP_MEMORY_SCOPE_AGENT); }
__device__ __forceinline__ unsigned xb_add(unsigned* p, unsigned v) { return __hip_atomic_fetch_add(p, v, __ATOMIC_RELAXED, __HIP_MEMORY_SCOPE_AGENT); }
__device__ __forceinline__ unsigned xb_xcc_id() { return (unsigned)__builtin_amdgcn_s_getreg((3 << 11) | 20) & 0xFu; }
#define XB_SPIN(cond, bar) do { unsigned _sp = 0; while (cond) { __builtin_amdgcn_s_sleep(1); \
    if ((++_sp & 255u) == 0u) { if (xb_ld(&(bar)[XB_TMO])) break; if (_sp > XB_SPIN_CAP) { atomicAdd(&(bar)[XB_TMO], 1u); break; } } } } while (0)
struct XcdBarrier { unsigned* bar; unsigned x; volatile LAS unsigned* st; int wv; };
__device__ __forceinline__ XcdBarrier xcd_barrier_post(unsigned* bar, volatile LAS unsigned* st, int wv) {
    XcdBarrier b; b.bar = bar; b.x = xb_xcc_id(); b.st = st; b.wv = wv;
    if (opaque_tid(wv) == 0) (void)xb_add(&bar[XB_XCNT(b.x)], 1u);
    return b;
}
__device__ __forceinline__ void xcd_barrier_complete(unsigned* bar, unsigned x, unsigned& nloc, unsigned& nx) {
    const unsigned G = gridDim.x * gridDim.y * gridDim.z;
    unsigned sum, cnt, mine, sp = 0u;
    for (;;) {
        sum = 0u; cnt = 0u; mine = 0u;
#pragma unroll
        for (unsigned j = 0; j < 16; ++j) { const unsigned c = xb_ld(&bar[XB_XCNT(j)]); sum += c; cnt += (c > 0u) ? 1u : 0u; mine = (j == x) ? c : mine; }
        if (sum == G) break;
        __builtin_amdgcn_s_sleep(1);
        if ((++sp & 255u) == 0u) { if (xb_ld(&bar[XB_TMO])) break; if (sp > XB_SPIN_CAP) { atomicAdd(&bar[XB_TMO], 1u); break; } }
    }
    nloc = mine > 0u ? mine : 1u; nx = cnt > 0u ? cnt : 1u;
}
__device__ __forceinline__ void xcd_barrier(const XcdBarrier& b) {
    asm volatile("s_waitcnt vmcnt(0)" ::: "memory");
    __syncthreads();
    if (opaque_tid(b.wv) == 0) {
        unsigned* bar = b.bar;
        __builtin_amdgcn_s_waitcnt(0);
        unsigned nloc = b.st[0], nx = b.st[1];
        if (nloc == 0u) { xcd_barrier_complete(bar, b.x, nloc, nx); b.st[0] = nloc; b.st[1] = nx; }
        const unsigned old = xb_add(&bar[XB_XSUB(b.x)], 1u);
        const unsigned gen = old / nloc;
        if (old + 1u == (gen + 1u) * nloc) {
            __builtin_amdgcn_fence(__ATOMIC_RELEASE, "agent");
            asm volatile("s_waitcnt vmcnt(0)" ::: "memory");
            const unsigned og = xb_add(&bar[XB_TOP], 1u);
            const unsigned tg = og / nx;
            if (og + 1u == (tg + 1u) * nx) xb_add(&bar[XB_TOPGEN], 1u);
            else XB_SPIN(xb_ld(&bar[XB_TOPGEN]) == tg, bar);
            __builtin_amdgcn_fence(__ATOMIC_ACQUIRE, "agent");
            xb_add(&bar[XB_XGEN(b.x)], 1u);
            asm volatile("s_waitcnt vmcnt(0)" ::: "memory");
        } else {
            XB_SPIN(xb_ld(&bar[XB_XGEN(b.x)]) == gen, bar);
            __builtin_amdgcn_fence(__ATOMIC_ACQUIRE, "agent");
            asm volatile("s_waitcnt vmcnt(0)" ::: "memory");
        }
    }
    __syncthreads();
}

template <int MAP> __device__ __forceinline__ int srccol(int n) {
    if constexpr (MAP == 1) { return n < 768 ? n : (n < 3840 ? n + 64 : (n < 3904 ? n - 3840 + 768 : -1)); }
    else if constexpr (MAP == 2) { const int hd = n / 192, cin = n - hd * 192; if (cin < 128) return n; const int t = cin - 128; return hd * 192 + 128 + (t >> 1) + 32 * (t & 1); }
    else if constexpr (MAP == 3) { return ((n >> 7) & 1) * DFF + (n >> 8) * 128 + (n & 127); }
    else return n;
}
template <int MAP>
__device__ __forceinline__ void transpose_item(const float* __restrict__ W, int K, int Nsrc, bf16* __restrict__ WT, LAS float* scr, int item, int nblk, int lane) {
    const int kb = item / nblk, nb = item - kb * nblk, k0 = 64 * kb, n0 = 32 * nb;
    const int scn = srccol<MAP>(n0 + (lane & 31));
    float wv[32];
    const float* wp = W + (size_t)(k0 + (lane >> 5)) * Nsrc + (scn >= 0 ? scn : 0);
#pragma unroll
    for (int i = 0; i < 32; ++i) wv[i] = wp[(size_t)(2 * i) * Nsrc];
#pragma unroll
    for (int i = 0; i < 32; ++i) { const int kk = 2 * i + (lane >> 5); scr[kk * 33 + (lane & 31)] = scn >= 0 ? wv[i] : 0.f; }
    LDS_WAIT(); asm volatile("" ::: "memory");
    const int c = lane & 7;
#pragma unroll
    for (int j = 0; j < 4; ++j) { const int n = (lane >> 3) + 8 * j; const LAS float* s = scr + (8 * c) * 33 + n;
        u32x4 o; o.x = pk2(s[0 * 33], s[1 * 33]); o.y = pk2(s[2 * 33], s[3 * 33]); o.z = pk2(s[4 * 33], s[5 * 33]); o.w = pk2(s[6 * 33], s[7 * 33]);
        *(u32x4*)(WT + (size_t)(n0 + n) * K + k0 + 8 * c) = o; }
    LDS_WAIT(); asm volatile("" ::: "memory");
}
struct Row8 { f32x4 v[8]; };
__device__ __forceinline__ void row_load(Row8& r, const float* src, int lane) {
#pragma unroll
    for (int j = 0; j < 8; ++j) r.v[j] = ((const f32x4*)src)[lane + 64 * j]; }
__device__ __forceinline__ float row_rstd(const Row8& r) { float ss = 0.f;
#pragma unroll
    for (int j = 0; j < 8; ++j) ss += (r.v[j].x * r.v[j].x + r.v[j].y * r.v[j].y) + (r.v[j].z * r.v[j].z + r.v[j].w * r.v[j].w);
    return 1.f / sqrtf(wave_sum(ss) * (1.f / DM) + RMS_EPS); }
__device__ __forceinline__ void norm_fin_bf16(const Row8& r, const float* g, bf16* dst, float* cp, int lane) {
    const float rstd = row_rstd(r);
#pragma unroll
    for (int j = 0; j < 8; ++j) { const f32x4 gg = ((const f32x4*)g)[lane + 64 * j]; const f32x4 v = r.v[j];
        u32x2 w; w.x = pk2(v.x * rstd * gg.x, v.y * rstd * gg.y); w.y = pk2(v.z * rstd * gg.z, v.w * rstd * gg.w);
        ((u32x2*)dst)[lane + 64 * j] = w;
        if (cp) ((f32x4*)cp)[lane + 64 * j] = v; }
}
__device__ __forceinline__ void norm_fin_f32(const Row8& r, const float* g, float* io, int lane) {
    const float rstd = row_rstd(r);
#pragma unroll
    for (int j = 0; j < 8; ++j) { const f32x4 gg = ((const f32x4*)g)[lane + 64 * j]; const f32x4 v = r.v[j]; f32x4 o; o.x = v.x * rstd * gg.x; o.y = v.y * rstd * gg.y; o.z = v.z * rstd * gg.z; o.w = v.w * rstd * gg.w;
        ((f32x4*)io)[lane + 64 * j] = o; }
}
#define ROW_STREAM(SRC, FIN) do { int _m = gw; if (_m < M) { Row8 _ra, _rb; row_load(_ra, SRC(_m), lane); \
    for (;;) { const int _m1 = _m + NGW; row_load(_rb, SRC(_m1 < M ? _m1 : _m), lane); FIN(_ra, _m); if (_m1 >= M) break; \
        const int _m2 = _m1 + NGW; row_load(_ra, SRC(_m2 < M ? _m2 : _m1), lane); FIN(_rb, _m1); if (_m2 >= M) break; _m = _m2; } } } while (0)
__device__ __forceinline__ void unpack8(u32x4 w, float (&f)[8]) { f[0] = bf_lo(w.x); f[1] = bf_hi(w.x); f[2] = bf_lo(w.y); f[3] = bf_hi(w.y); f[4] = bf_lo(w.z); f[5] = bf_hi(w.z); f[6] = bf_lo(w.w); f[7] = bf_hi(w.w); }
__device__ __forceinline__ void postz_row(bf16* __restrict__ z, const float* __restrict__ gq, const float* __restrict__ gkv, const float* __restrict__ rope, bf16* __restrict__ kmrow, int row, int lane, bf16* __restrict__ cqn, bf16* __restrict__ ckvn, float* __restrict__ qn, float* __restrict__ kn, float* __restrict__ sf) {
    { float fq[8], fk[8]; unpack8(*(const u32x4*)(z + Z_DQ + lane * 8), fq); unpack8(*(const u32x4*)(z + Z_DK + lane * 8), fk); float sq = 0.f, sk = 0.f;
#pragma unroll
      for (int e = 0; e < 8; ++e) { sq += fq[e] * fq[e]; sk += fk[e] * fk[e]; }
      sq += swz_xor<1>(sq); sq += swz_xor<2>(sq); sq += swz_xor<4>(sq); sk += swz_xor<1>(sk); sk += swz_xor<2>(sk); sk += swz_xor<4>(sk);
      float sd = 0.f;
#pragma unroll
      for (int e = 0; e < 8; ++e) sd += fq[e] * fk[e];
      sd += swz_xor<1>(sd); sd += swz_xor<2>(sd); sd += swz_xor<4>(sd);
      if ((lane & 7) == 0) { qn[lane >> 3] = sq; kn[lane >> 3] = sk; sf[lane >> 3] = sd; } }
    { const u32x4 w = *(const u32x4*)(z + Z_CQ + lane * 8); float f[8]; unpack8(w, f); float ss = 0.f;
#pragma unroll
      for (int e = 0; e < 8; ++e) ss += f[e] * f[e];
      const float rstd = 1.f / sqrtf(wave_sum(ss) * (1.f / 512.f) + RMS_EPS);
      const f32x4 g0 = *(const f32x4*)(gq + lane * 8), g1 = *(const f32x4*)(gq + lane * 8 + 4);
      u32x4 o; o.x = pk2(f[0] * rstd * g0.x, f[1] * rstd * g0.y); o.y = pk2(f[2] * rstd * g0.z, f[3] * rstd * g0.w); o.z = pk2(f[4] * rstd * g1.x, f[5] * rstd * g1.y); o.w = pk2(f[6] * rstd * g1.z, f[7] * rstd * g1.w);
      *(u32x4*)(cqn + lane * 8) = o; }
    { const int l2 = lane & 31; const u32x4 w = *(const u32x4*)(z + Z_CKV + l2 * 8); float f[8]; unpack8(w, f); float ss = 0.f;
#pragma unroll
      for (int e = 0; e < 8; ++e) ss += f[e] * f[e];
      if (lane >= 32) ss = 0.f;
      const float rstd = 1.f / sqrtf(wave_sum(ss) * (1.f / 256.f) + RMS_EPS);
      const f32x4 g0 = *(const f32x4*)(gkv + l2 * 8), g1 = *(const f32x4*)(gkv + l2 * 8 + 4);
      u32x4 o; o.x = pk2(f[0] * rstd * g0.x, f[1] * rstd * g0.y); o.y = pk2(f[2] * rstd * g0.z, f[3] * rstd * g0.w); o.z = pk2(f[4] * rstd * g1.x, f[5] * rstd * g1.y); o.w = pk2(f[6] * rstd * g1.z, f[7] * rstd * g1.w);
      if (lane < 32) *(u32x4*)(ckvn + l2 * 8) = o; }
    if (lane < 32) { const float x1 = bf_lo((unsigned)z[Z_KPE + lane]), x2 = bf_lo((unsigned)z[Z_KPE + 32 + lane]);
      const int pos = row & seq_mask(row); const f32x2 cs = *(const f32x2*)(rope + ((size_t)pos * 32 + lane) * 2);
      const unsigned w = pk2(x1 * cs.x - x2 * cs.y, x1 * cs.y + x2 * cs.x);
#pragma unroll
      for (int h = 0; h < 8; ++h) *(unsigned*)(kmrow + h * 192 + 128 + 2 * lane) = w; }
}
__device__ __forceinline__ void diffc_row(const float* __restrict__ o1, const float* __restrict__ o2, const float* __restrict__ gs, float lam, float post, bf16* __restrict__ mixrow, int lane) {
    const f32x4 a0 = *(const f32x4*)(o1 + lane * 8), a1 = *(const f32x4*)(o1 + lane * 8 + 4), b0 = *(const f32x4*)(o2 + lane * 8), b1 = *(const f32x4*)(o2 + lane * 8 + 4);
    const f32x4 d0 = a0 - b0 * lam, d1 = a1 - b1 * lam;
    float ss = (d0.x * d0.x + d0.y * d0.y) + (d0.z * d0.z + d0.w * d0.w) + (d1.x * d1.x + d1.y * d1.y) + (d1.z * d1.z + d1.w * d1.w);
    ss = half_sum16(ss);
    const float r = post / sqrtf(ss * (1.f / 128.f) + RMS_EPS);
    const f32x4 g0 = *(const f32x4*)(gs + (lane & 15) * 8), g1 = *(const f32x4*)(gs + (lane & 15) * 8 + 4);
    u32x4 o; o.x = pk2(d0.x * r * g0.x, d0.y * r * g0.y); o.y = pk2(d0.z * r * g0.z, d0.w * r * g0.w); o.z = pk2(d1.x * r * g1.x, d1.y * r * g1.y); o.w = pk2(d1.z * r * g1.z, d1.w * r * g1.w);
    *(u32x4*)(mixrow + 1536 + lane * 8) = o;
}


__device__ const float ROPE_FREQ[32] = {1.000000000e+00f, 7.498942614e-01f, 5.623413324e-01f, 4.216965139e-01f, 3.162277639e-01f, 2.371373773e-01f, 1.778279394e-01f, 1.333521307e-01f, 1.000000015e-01f, 7.498941571e-02f, 5.623413250e-02f, 4.216965288e-02f, 3.162277490e-02f, 2.371373773e-02f, 1.778279431e-02f, 1.333521493e-02f, 9.999999776e-03f, 7.498941850e-03f, 5.623413250e-03f, 4.216964822e-03f, 3.162277630e-03f, 2.371373586e-03f, 1.778279431e-03f, 1.333521446e-03f, 1.000000047e-03f, 7.498942432e-04f, 5.623413017e-04f, 4.216965172e-04f, 3.162277571e-04f, 2.371373703e-04f, 1.778279402e-04f, 1.333521504e-04f};
constexpr int PH_PER_LAYER = 12, N_PHASES = DEPTH * PH_PER_LAYER + 1;
struct Args { const float* in[26]; float* out; unsigned char* ws; int ph_lo, ph_hi, sub, pad; };
enum { I_XP = 0, I_XS, I_PP, I_PS, I_GATTN, I_WIN, I_GQA, I_WQB, I_GKVA, I_WKVB, I_RPB, I_LQ1, I_LK1, I_LQ2, I_LK2, I_GSUB, I_WOUT, I_GFFN, I_WGU, I_CONVW, I_CONVB, I_WDOWN, I_GPLE, I_WPLG, I_WPLE, I_GFINAL };

typedef const __attribute__((address_space(4))) Args* ArgsP;
__device__ __forceinline__ ArgsP site_args() { ArgsP p = (ArgsP)__builtin_amdgcn_kernarg_segment_ptr(); asm volatile("" : "+s"(p)); return p; }
#ifndef PH_MASK
#define PH_MASK 0x1fff
#endif
#ifndef SUB_MASK
#define SUB_MASK 0xff
#endif
#define SUB(k) ((submask >> (k)) & 1)

__global__ void __launch_bounds__(NWAVES * 64, 2) fwd(Args args_unused) {
    extern __shared__ __attribute__((aligned(16))) unsigned char lds_raw[];
    LAS unsigned char* lds = (LAS unsigned char*)lds_raw;
    const int G = gridDim.x; const int bx = blockIdx.x; const int vcu = (G % 8 == 0) ? (bx % 8) * (G / 8) + bx / 8 : bx;
    { const int tid = threadIdx.x; for (int u = tid; u < (LDS_BYTES - RING_BYTES) / 4; u += NWAVES * 64) ((LAS unsigned*)(lds + RING_BYTES))[u] = 0u; }
    __syncthreads();
    const int wave0 = __builtin_amdgcn_readfirstlane((int)threadIdx.x >> 6);
    int lo, hi, submask;
    XcdBarrier bar;
    { ArgsP ap = site_args(); lo = ap->ph_lo; hi = ap->ph_hi; submask = ap->sub; unsigned* ctl = (unsigned*)(ap->ws + WS_CTL);
      bar.bar = ctl + CW_BAR; bar.x = 0; bar.st = (volatile LAS unsigned*)(lds + MISC_OFF) + 8; bar.wv = wave0;
      if (hi - lo > 1) bar = xcd_barrier_post(ctl + CW_BAR, (volatile LAS unsigned*)(lds + MISC_OFF) + 8, wave0); }
#define IN(k) (((PH_MASK >> (((k) >= DEPTH * PH_PER_LAYER) ? 12 : ((k) % PH_PER_LAYER))) & 1) && lo <= (k) && (k) < hi)
#define SEAM(k) do { if (IN(k) && IN((k) + 1)) xcd_barrier(bar); } while (0)
#define SITE() ArgsP ap = site_args(); unsigned char* const ws = ap->ws; const int tid = opaque_tid(wave0), lane = tid & 63, wave = __builtin_amdgcn_readfirstlane(tid >> 6); \
    const int gw = vcu * NWAVES + wave, NGW = G * NWAVES; (void)gw; (void)NGW; (void)lane; (void)ws
#define WSP(T, off) ((T*)(ws + (off)))

    for (int l = 0; l < DEPTH; ++l) {
        const int P0 = l * PH_PER_LAYER;
        if (IN(P0 + 0)) { SITE();
            const int gt = vcu * (NWAVES * 64) + tid, NGT = G * NWAVES * 64;
            LAS float* scr = (LAS float*)(lds + wave * 16384);
            constexpr int I0 = 32 * 128, I1 = I0 + 8 * 48, I2 = I1 + 4 * 64, I3 = I2 + 32 * 64, I4 = I3 + 32 * 352, I5 = I4 + 88 * 64, I6 = I5 + 32 * 64, I7 = I6 + 4 * 64;
            for (int it = gw; it < I7; it += NGW) {
                if (it < I0) transpose_item<1>(ap->in[I_WIN] + (size_t)l * DM * IN_W, DM, IN_W, WSP(bf16, WS_WIN), scr, it, 128, lane);
                else if (it < I1) transpose_item<2>(ap->in[I_WQB] + (size_t)l * 512 * QW, 512, QW, WSP(bf16, WS_WQB), scr, it - I0, 48, lane);
                else if (it < I2) transpose_item<0>(ap->in[I_WKVB] + (size_t)l * 256 * KVW, 256, KVW, WSP(bf16, WS_WKVB), scr, it - I1, 64, lane);
                else if (it < I3) transpose_item<0>(ap->in[I_WOUT] + (size_t)l * DM * DM, DM, DM, WSP(bf16, WS_WOUT), scr, it - I2, 64, lane);
                else if (it < I4) transpose_item<3>(ap->in[I_WGU] + (size_t)l * DM * 2 * DFF, DM, 2 * DFF, WSP(bf16, WS_WGU), scr, it - I3, 352, lane);
                else if (it < I5) transpose_item<0>(ap->in[I_WDOWN] + (size_t)l * DFF * DM, DFF, DM, WSP(bf16, WS_WDOWN), scr, it - I4, 64, lane);
                else if (it < I6) transpose_item<0>(ap->in[I_WPLG] + (size_t)l * DM * DM, DM, DM, WSP(bf16, WS_WPLG), scr, it - I5, 64, lane);
                else transpose_item<0>(ap->in[I_WPLE] + (size_t)l * PLE * DM, PLE, DM, WSP(bf16, WS_WPLE), scr, it - I6, 64, lane);
            }
            { bf16* PB = WSP(bf16, WS_PB); const float* pp = ap->in[I_PP] + (size_t)l * MP * PLE; const float* ps = ap->in[I_PS] + (size_t)l * MS * PLE;
              for (int i = gt; i < M * (PLE / 8); i += NGT) { const int row = i >> 5, c = (i & 31) * 8;
                const float* src = row < MP ? pp + (size_t)row * PLE + c : ps + (size_t)(row - MP) * PLE + c;
                const f32x4 a = *(const f32x4*)src, b = *(const f32x4*)(src + 4);
                u32x4 o; o.x = pk2(a.x, a.y); o.y = pk2(a.z, a.w); o.z = pk2(b.x, b.y); o.w = pk2(b.z, b.w); *(u32x4*)(PB + (size_t)row * PLE + c) = o; } }
            if (l == 0) { float* ROPE = WSP(float, WS_ROPE);
                for (int i = gt; i < LP * 32; i += NGT) { const int pos = i >> 5, j = i & 31;
                    const float freq = ROPE_FREQ[j];
                    const float ang = (float)pos * freq;
                    double rev = (double)ang * 0.15915494309189535; rev -= floor(rev);
                    const float fr = (float)rev;
                    f32x2 cs; cs.x = __builtin_amdgcn_cosf(fr); cs.y = __builtin_amdgcn_sinf(fr); *(f32x2*)(ROPE + (size_t)i * 2) = cs; } }
            { bf16* AB = WSP(bf16, WS_A); float* H = ap->out; const float* g = ap->in[I_GATTN] + l * DM; const float* xp = ap->in[I_XP]; const float* xs = ap->in[I_XS];
#define P0_SRC(m) (l == 0 ? ((m) < MP ? xp + (size_t)(m) * DM : xs + (size_t)((m) - MP) * DM) : (const float*)H + (size_t)(m) * DM)
#define P0_FIN(r, m) norm_fin_bf16(r, g, AB + (size_t)(m) * DM, nullptr, lane)
              ROW_STREAM(P0_SRC, P0_FIN); }
#undef P0_SRC
#undef P0_FIN
        }
        SEAM(P0 + 0);
        if (IN(P0 + 1)) { SITE(); pg8::Gemm g{WSP(bf16, WS_A), WSP(bf16, WS_WIN), DM, DM}; pg8::StaticOrder S; S.init(M / 256, ZLD / 256, G, bx); pg8::EpiZ E{WSP(bf16, WS_Z)};
            pg8::gemm_phase<pg8::EpiZ, false>(lds, g, S, E, wave0); }
        SEAM(P0 + 1);
        if (IN(P0 + 2)) { SITE(); bf16* Z = WSP(bf16, WS_Z); bf16* KM = WSP(bf16, WS_KM); const float* ROPE = WSP(float, WS_ROPE); const float* gq = ap->in[I_GQA] + l * 512; const float* gkv = ap->in[I_GKVA] + l * 256;
            for (int m = gw; m < M; m += NGW) postz_row(Z + (size_t)m * ZLD, gq, gkv, ROPE, KM + (size_t)m * QW, m, lane, WSP(bf16, WS_CQN) + (size_t)m * 512, WSP(bf16, WS_CKVN) + (size_t)m * 256, WSP(float, WS_QN) + (size_t)m * 8, WSP(float, WS_KN) + (size_t)m * 8, WSP(float, WS_SELF) + (size_t)m * 8);
        }
        SEAM(P0 + 2);
        if (IN(P0 + 3)) {
            if (SUB(0)) { SITE(); pg8::Gemm g{WSP(bf16, WS_CKVN), WSP(bf16, WS_WKVB), 256, 256}; pg8::StaticOrder S; S.init(M / 256, KVW / 256, G, bx); pg8::EpiKV E{WSP(bf16, WS_KM), WSP(bf16, WS_VM)}; pg8::gemm_phase<pg8::EpiKV, false>(lds, g, S, E, wave0); }
            if (SUB(1)) { SITE(); pg8::Gemm g{WSP(bf16, WS_CQN), WSP(bf16, WS_WQB), 512, 512}; pg8::StaticOrder S; S.init(M / 256, QW / 256, G, bx); pg8::EpiQ E{WSP(bf16, WS_QM), WSP(float, WS_ROPE)}; pg8::gemm_phase<pg8::EpiQ, false>(lds, g, S, E, wave0); }
        }
        SEAM(P0 + 3);
        if (IN(P0 + 4)) {
            char* alds = (char*)lds_raw;
            if (SUB(2)) { SITE(); const bf16* QM = WSP(bf16, WS_QM); const bf16* KM = WSP(bf16, WS_KM); const bf16* VM = WSP(bf16, WS_VM); bf16* AB = WSP(bf16, WS_A);
              for (int u = vcu; u < 1024 + 512; u += G) {
                int s0, L, h, qb;
                if (u < 1024) { const int bh = u >> 6; qb = u & 63; h = bh & 7; s0 = (bh >> 3) * LP; L = LP; }
                else { const int v = u - 1024, bh = v >> 3; qb = v & 7; h = bh & 7; s0 = MP + (bh >> 3) * LS; L = LS; }
                att::Hook Hk{};
                att::attn_body<192, 0, QW, QW, VW, DM, bf16>(QM + (size_t)(s0 + qb * 256) * QW + h * 192, KM + (size_t)s0 * QW + h * 192, VM + (size_t)s0 * VW + h * 128,
                                                           AB + (size_t)(s0 + qb * 256) * DM + h * 128, L / 64, Hk, alds, wave0);
                __syncthreads();
              } }
            if (SUB(3)) { SITE(); const bf16* Z = WSP(bf16, WS_Z); float* DOB = WSP(float, WS_DO); const float* QN = WSP(float, WS_QN); const float* KN = WSP(float, WS_KN); const float* SF = WSP(float, WS_SELF); const int r32 = lane & 31, hi5 = lane >> 5;
              LAS float* red = (LAS float*)(lds + att::OFF_TAB);
              unsigned* dyn = (unsigned*)(ws + WS_CTL) + CW_DYN + l;
              for (int u = vcu, dynamic = 0;;) {
                if (!dynamic && u >= 1024) dynamic = 1;
                if (dynamic) {
                    if (tid == 0) ((LAS unsigned*)red)[32] = xb_add(dyn, 1u);
                    __syncthreads();
                    const unsigned w = (unsigned)__builtin_amdgcn_readfirstlane((int)((LAS unsigned*)red)[32]);
                    if (w >= 512u) break;
                    u = 1024 + (int)w; }
                int s0, L, h, mp, qb;
                if (u < 1024) { const int r = u >> 8, g = (u >> 6) & 3; qb = u & 63; h = (g + r) & 3; mp = r & 1; s0 = (r >> 1) * LP; L = LP; }
                else { const int v = u - 1024, rem = v & 127; h = 3 - (v >> 7); qb = rem & 7; mp = (rem >> 3) & 1; s0 = MP + (rem >> 4) * LS; L = LS; }
                const int vec = h * 2 + mp, q0 = qb * 256;
                { const int t2 = opaque_tid(wave0); float k2 = 0.f; for (int r = t2; r < L; r += NWAVES * 64) k2 = fmaxf(k2, KN[(size_t)(s0 + r) * 8 + vec]);
                  float q2 = t2 < 256 ? QN[(size_t)(s0 + q0 + t2) * 8 + vec] : 0.f;
                  float ns = t2 < 256 ? -SF[(size_t)(s0 + q0 + t2) * 8 + vec] : -3.0e38f;
                  k2 = wave_max(k2); q2 = wave_max(q2); ns = wave_max(ns);
                  if ((t2 & 63) == 0) { red[t2 >> 6] = k2; red[8 + (t2 >> 6)] = q2; red[16 + (t2 >> 6)] = ns; } }
                __syncthreads();
                float k2 = red[0], q2 = red[8], ns = red[16];
#pragma unroll
                for (int i = 1; i < 8; ++i) { k2 = fmaxf(k2, red[i]); q2 = fmaxf(q2, red[8 + i]); ns = fmaxf(ns, red[16 + i]); }
                const float slope2 = LOG2E * exp2f(-2.f * (float)(h + 1));
                const float dstar = (1.01f * sqrtf(k2 * q2) + ns + 0.05f + 152.f) / slope2;
                const int NTall = L / 64; int tlo = 0, thi = NTall;
                if (dstar < 1.0e6f) { const int D = (int)dstar + 2; tlo = (q0 - D - 63) / 64; tlo = tlo < 0 ? 0 : tlo; thi = (q0 + 255 + D) / 64 + 1; thi = thi > NTall ? NTall : thi; }
                if ((thi - tlo) & 1) { if (thi < NTall) ++thi; else --tlo; }
                tlo = __builtin_amdgcn_readfirstlane(tlo); thi = __builtin_amdgcn_readfirstlane(thi);
                att::Hook Hk{}; Hk.dl = (float)(q0 - 64 * tlo + wave * 32 + r32 - 4 * hi5); Hk.nslope = -slope2; Hk.tq0 = q0 - 64 * tlo + wave * 32; Hk.sref = SF[(size_t)(s0 + q0 + wave * 32 + r32) * 8 + vec];
                att::attn_body<64, 1, ZLD, ZLD, ZLD, 512, float>(Z + (size_t)(s0 + q0) * ZLD + Z_DQ + h * 128 + mp * 64, Z + (size_t)(s0 + 64 * tlo) * ZLD + Z_DK + h * 128 + mp * 64, Z + (size_t)(s0 + 64 * tlo) * ZLD + Z_DV + h * 128,
                                                               DOB + (size_t)mp * M * 512 + (size_t)(s0 + q0) * 512 + h * 128, thi - tlo, Hk, alds, wave0);
                __syncthreads();
                if (!dynamic) u += G;
              } }
            if (SUB(4)) { SITE(); const bf16* Z = WSP(bf16, WS_Z); bf16* AB = WSP(bf16, WS_A); const float* rpb = ap->in[I_RPB] + (size_t)l * 4 * 15 * 31; const int r32 = lane & 31, hi5 = lane >> 5;
              for (int u = vcu; u < (M / 256) * 4; u += G) {
                const int h = u & 3, row0 = (u >> 2) * 256;
                const int L = row0 < MP ? LP : LS, s0 = row0 < MP ? (row0 & ~(LP - 1)) : (MP + ((row0 - MP) & ~(LS - 1)));
                const int rows = L / 64, R0 = (row0 - s0) / 64;
                int tlo = R0 - 4; tlo = tlo < 0 ? 0 : (tlo > rows - 12 ? rows - 12 : tlo);
                LAS float* tab = (LAS float*)(lds + 98304);
                { const int t2 = opaque_tid(wave0);
                  for (int i = t2; i < 15 * 16 * 18; i += NWAVES * 64) { const int e = i % 18, q = i / 18, lo_ = q & 15, tr_ = q >> 4, d = e - 1;
                      tab[i] = (d >= 0 && d < 16) ? rpb[((size_t)h * 15 + tr_) * 31 + d + lo_] * LOG2E : att::NEG_BIG; } }
                __syncthreads();
                att::Hook Hk{}; const int qc = (wave & 1) * 32 + r32; int cs = qc - 8; cs = cs < 0 ? 0 : (cs > 48 ? 48 : cs);
                Hk.relbase = 4 * hi5 - cs + 1; Hk.lo = cs - qc + 15; Hk.qgr = R0 + (wave >> 1); int rs = Hk.qgr - 4; rs = rs < 0 ? 0 : (rs > rows - 8 ? rows - 8 : rs); Hk.rs = rs; Hk.kr0 = tlo; Hk.tab = tab;
                att::attn_body<128, 2, ZLD, ZLD, ZLD, DM, bf16>(Z + (size_t)row0 * ZLD + Z_NAQ + h * 128, Z + (size_t)(s0 + tlo * 64) * ZLD + Z_NAK + h * 128, Z + (size_t)(s0 + tlo * 64) * ZLD + Z_NAV + h * 128,
                                                              AB + (size_t)row0 * DM + 1024 + h * 128, 12, Hk, alds, wave0);
                __syncthreads();
              } }
        }
        SEAM(P0 + 4);
        if (IN(P0 + 5)) { SITE();
            float s1 = ap->in[I_LQ1][l * 64 + lane] * ap->in[I_LK1][l * 64 + lane], s2 = ap->in[I_LQ2][l * 64 + lane] * ap->in[I_LK2][l * 64 + lane];
            s1 = wave_sum(s1); s2 = wave_sum(s2);
            int lq = l; asm volatile("" : "+s"(lq));
            const float lam_init = lq == 0 ? 0.2f : (lq == 1 ? 0.35550906759096926f : (lq == 2 ? 0.47071301834358414f : 0.5560582041556405f));
            const float lam = expf(s1) - expf(s2) + lam_init;
            const float* DOB = WSP(float, WS_DO); bf16* AB = WSP(bf16, WS_A); const float* gs = ap->in[I_GSUB] + l * 128;
            for (int m = gw; m < M; m += NGW) diffc_row(DOB + (size_t)m * 512, DOB + (size_t)M * 512 + (size_t)m * 512, gs, lam, 1.f - lam_init, AB + (size_t)m * DM, lane);
        }
        SEAM(P0 + 5);
        if (IN(P0 + 6)) { SITE(); pg8::Gemm g{WSP(bf16, WS_A), WSP(bf16, WS_WOUT), DM, DM}; pg8::StaticOrder S; S.init(M / 256, DM / 256, G, bx); pg8::EpiRes E{ap->out, l == 0 ? ap->in[I_XP] : nullptr, ap->in[I_XS]}; pg8::gemm_phase<pg8::EpiRes, false>(lds, g, S, E, wave0); }
        SEAM(P0 + 6);
#define HN_SRC(m) (H + (size_t)(m) * DM)
#define HN_FIN(r, m) norm_fin_bf16(r, g, AB + (size_t)(m) * DM, nullptr, lane)
        if (IN(P0 + 7)) { SITE(); const float* H = ap->out; bf16* AB = WSP(bf16, WS_A); const float* g = ap->in[I_GFFN] + l * DM;
            ROW_STREAM(HN_SRC, HN_FIN); }
        SEAM(P0 + 7);
        if (IN(P0 + 8)) { SITE(); pg8::Gemm g{WSP(bf16, WS_A), WSP(bf16, WS_WGU), DM, DM}; pg8::StaticOrder S; S.init(GU_NM, (2 * DFF) / 256, G, bx);
            pg8::EpiGU E{WSP(bf16, WS_ACT), ap->in[I_CONVW] + (size_t)l * 3 * DFF, ap->in[I_CONVB] + (size_t)l * DFF};
            pg8::gemm_phase<pg8::EpiGU, true>(lds, g, S, E, wave0); }
        SEAM(P0 + 8);
        if (IN(P0 + 9)) { SITE(); pg8::Gemm g{WSP(bf16, WS_ACT), WSP(bf16, WS_WDOWN), DFF, DFF}; pg8::StaticOrder S; S.init(M / 256, DM / 256, G, bx); pg8::EpiRes E{ap->out, nullptr, nullptr}; pg8::gemm_phase<pg8::EpiRes, false>(lds, g, S, E, wave0); }
        SEAM(P0 + 9);
        if (IN(P0 + 10)) {
            const int NORM_WG = (G == 256 && submask == 0xff) ? 136 : 0;
            if (NORM_WG == 0) {
                if (SUB(5)) { SITE(); const float* H = ap->out; bf16* AB = WSP(bf16, WS_A); const float* g = ap->in[I_GPLE] + l * DM;
                    ROW_STREAM(HN_SRC, HN_FIN); }
                __syncthreads();
                if (SUB(6)) { SITE(); pg8::Gemm g{WSP(bf16, WS_PB), WSP(bf16, WS_WPLE), PLE, PLE}; pg8::StaticOrder S; S.init(M / 256, DM / 256, G, bx); pg8::EpiStore E{WSP(bf16, WS_PLEB), DM}; pg8::gemm_phase<pg8::EpiStore, false>(lds, g, S, E, wave0); }
            } else if (bx < NORM_WG) { SITE(); const float* H = ap->out; bf16* AB = WSP(bf16, WS_A); const float* g = ap->in[I_GPLE] + l * DM;
                { const int gw = bx * NWAVES + wave, NGW = NORM_WG * NWAVES; ROW_STREAM(HN_SRC, HN_FIN); }
            } else { SITE(); pg8::Gemm g{WSP(bf16, WS_PB), WSP(bf16, WS_WPLE), PLE, PLE}; pg8::StaticOrder S; S.init(M / 256, DM / 256, G - NORM_WG, bx - NORM_WG); pg8::EpiStore E{WSP(bf16, WS_PLEB), DM}; pg8::gemm_phase<pg8::EpiStore, false>(lds, g, S, E, wave0); }
        }
        SEAM(P0 + 10);
        if (IN(P0 + 11)) { SITE(); pg8::Gemm g{WSP(bf16, WS_A), WSP(bf16, WS_WPLG), DM, DM}; pg8::StaticOrder S; S.init(M / 256, DM / 256, G, bx); pg8::EpiPlg E{ap->out, WSP(bf16, WS_PLEB)}; pg8::gemm_phase<pg8::EpiPlg, false>(lds, g, S, E, wave0); }
        SEAM(P0 + 11);
    }
#define FN_FIN(r, m) norm_fin_f32(r, g, H + (size_t)(m) * DM, lane)
    if (IN(DEPTH * PH_PER_LAYER)) { SITE(); float* H = ap->out; const float* g = ap->in[I_GFINAL]; ROW_STREAM(HN_SRC, FN_FIN);
    }
#undef IN
#undef SEAM
#undef SITE
#undef WSP
}

extern "C" void kernel_launch(void* const* d_in, const int* in_sizes, int n_in, void* d_out, int out_size, void* d_ws, size_t ws_size, hipStream_t stream) {
    static int grid = 0;
    if (grid == 0) {
        if (n_in != 26 || out_size != M * DM || ws_size < WS_END) { fprintf(stderr, "kernel_launch: expected 26 inputs, out %d, ws >= %zu; got n_in %d out %d ws %zu\n", M * DM, (size_t)WS_END, n_in, out_size, ws_size); grid = -1; return; }
        int dev = 0, cus = 0, per_cu = 0;
        if (hipGetDevice(&dev) != hipSuccess || hipDeviceGetAttribute(&cus, hipDeviceAttributeMultiprocessorCount, dev) != hipSuccess) { grid = -1; return; }
        if (hipFuncSetAttribute((const void*)fwd, hipFuncAttributeMaxDynamicSharedMemorySize, LDS_BYTES) != hipSuccess) { fprintf(stderr, "kernel_launch: hipFuncSetAttribute failed\n"); grid = -1; return; }
        if (hipOccupancyMaxActiveBlocksPerMultiprocessor(&per_cu, (const void*)fwd, NWAVES * 64, LDS_BYTES) != hipSuccess || per_cu < 1) { fprintf(stderr, "kernel_launch: occupancy query says %d\n", per_cu); }
        (void)hipGetLastError();
        grid = cus;
    }
    if (grid < 0) return;
    (void)hipMemsetAsync((char*)d_ws + WS_CTL, 0, CTL_ZERO_BYTES, stream);
    Args a{};
    for (int i = 0; i < 26; ++i) a.in[i] = (const float*)d_in[i];
    a.out = (float*)d_out; a.ws = (unsigned char*)d_ws; a.sub = 0xff; a.pad = 0;
#if MK_ONE_LAUNCH
    a.ph_lo = 0; a.ph_hi = N_PHASES;
    hipLaunchKernelGGL(fwd, dim3(grid), dim3(NWAVES * 64), LDS_BYTES, stream, a);
#else
    for (int p = 0; p < N_PHASES; ++p) { a.ph_lo = p; a.ph_hi = p + 1; a.sub = 0xff; hipLaunchKernelGGL(fwd, dim3(grid), dim3(NWAVES * 64), LDS_BYTES, stream, a);
#ifdef DUP_PH
        if (p < DEPTH * PH_PER_LAYER && (p % PH_PER_LAYER) == DUP_PH) { a.sub = DUP_SUB; hipLaunchKernelGGL(fwd, dim3(grid), dim3(NWAVES * 64), LDS_BYTES, stream, a); }
#endif
    }
#endif
    const hipError_t le = hipPeekAtLastError();
    if (le != hipSuccess) fprintf(stderr, "kernel_launch: launch failed: %s\n", hipGetErrorName(le));
}
```
